# Optimizing an MI355X kernel written in HIP

```python
import math
import jax, jax.numpy as jnp
from jax import lax
import numpy as np

D_MODEL = 1024
BATCH = 16
SEQ = 256
DEPTH = 2
DEC_BATCH = 4
DEC_SEQ = 1024
PAST_LEN = 256

GRID_W = 64
D_FF = 2816
N_MODS = 9
CONV_DIM = 512
CONV_WIDTH = 31
RET_HEADS = 4
RET_DK = 128
RET_DV = 256
RET_CHUNK = 128
MLA_HEADS = 8
MLA_Q_LORA = 512
MLA_KV_LORA = 256
MLA_D_NOPE = 64
MLA_D_ROPE = 32
MLA_D_V = 64
ROPE_AXIS_HALF = MLA_D_ROPE // 4
ROPE_BASE = 10000.0
Q_BLOCK = 128
N_BRANCHES = 3
DEEPNORM_ALPHA = (2 * DEPTH) ** 0.25
DEEPNORM_BETA = (8 * DEPTH) ** -0.25
LN_EPS = 1e-5
RMS_EPS = 1e-6
MIX_WIDTHS = (CONV_DIM, CONV_DIM, RET_HEADS * RET_DK, RET_HEADS * RET_DK, RET_HEADS * RET_DV,
              RET_HEADS * RET_DV, MLA_Q_LORA, MLA_KV_LORA, MLA_D_ROPE, N_BRANCHES * D_MODEL)
MIX_IN = sum(MIX_WIDTHS)
MIX_SPLITS = tuple(int(s) for s in np.cumsum(MIX_WIDTHS)[:-1])

kernel_name = 'hybrid_flow_prefix_trunk_step'


def layer_norm(x, g, b):
    xf = x.astype(jnp.float32)
    mu = jnp.mean(xf, -1, keepdims=True)
    var = jnp.mean(jnp.square(xf - mu), -1, keepdims=True)
    return ((xf - mu) * lax.rsqrt(var + LN_EPS)).astype(x.dtype) * g + b


def head_norm(x):
    xf = x.astype(jnp.float32)
    mu = jnp.mean(xf, -1, keepdims=True)
    var = jnp.mean(jnp.square(xf - mu), -1, keepdims=True)
    return ((xf - mu) * lax.rsqrt(var + LN_EPS)).astype(x.dtype)


def rms_norm(x, g):
    xf = x.astype(jnp.float32)
    return (xf * lax.rsqrt(jnp.mean(jnp.square(xf), -1, keepdims=True) + RMS_EPS)).astype(x.dtype) * g


def modulate(x, shift, scale):
    return x * (1 + scale) + shift


def swiglu(x, w_in, w_out):
    gate, up = jnp.split(x @ w_in, 2, axis=-1)
    return (jax.nn.silu(gate) * up) @ w_out


def axial_rope_tables(n_tokens, dtype):
    rows = n_tokens // GRID_W
    row_id = jnp.repeat(jnp.arange(rows, dtype=jnp.float32), GRID_W)
    col_id = jnp.tile(jnp.arange(GRID_W, dtype=jnp.float32), rows)
    inv_freq = ROPE_BASE ** (-jnp.arange(ROPE_AXIS_HALF, dtype=jnp.float32) / ROPE_AXIS_HALF)
    ang = jnp.stack([row_id[:, None] * inv_freq, col_id[:, None] * inv_freq], axis=1)
    return jnp.cos(ang).astype(dtype), jnp.sin(ang).astype(dtype)


def apply_axial_rope(x, cos, sin):
    xs = x.reshape(x.shape[:-1] + (2, 2, ROPE_AXIS_HALF))
    x1, x2 = xs[..., 0, :], xs[..., 1, :]
    out = jnp.stack([x1 * cos - x2 * sin, x1 * sin + x2 * cos], axis=-2)
    return out.reshape(x.shape)


def conformer_conv(a, g, w_dw, b_dw, ln_g, ln_b, w_out):
    h = a * jax.nn.sigmoid(g)
    h = lax.conv_general_dilated(h, w_dw[:, None, :], (1,), ((CONV_WIDTH // 2, CONV_WIDTH // 2),),
                                 dimension_numbers=('NWC', 'WIO', 'NWC'),
                                 feature_group_count=CONV_DIM) + b_dw
    h = jax.nn.silu(layer_norm(h, ln_g, ln_b))
    return h @ w_out


def retention_chunkwise(q, k, v, log_g, s0, strict):
    f32 = jnp.float32
    B, T, H, dk = q.shape
    dv = v.shape[-1]
    n = T // RET_CHUNK
    qc = q.astype(f32).reshape(B, n, RET_CHUNK, H, dk)
    kc = k.astype(f32).reshape(B, n, RET_CHUNK, H, dk)
    vc = v.astype(f32).reshape(B, n, RET_CHUNK, H, dv)
    idx = jnp.arange(RET_CHUNK, dtype=f32)
    diff = idx[:, None] - idx[None, :]
    keep = diff > 0 if strict else diff >= 0
    dmask = jnp.where(keep, jnp.exp(jnp.where(keep, diff, 0.0)[None] * log_g[:, None, None]), 0.0)
    scores = jnp.einsum('bnihd,bnjhd->bnhij', qc, kc) * dmask
    inner = jnp.einsum('bnhij,bnjhe->bnihe', scores, vc)
    zeta = jnp.exp((RET_CHUNK - 1.0 - idx)[None, :] * log_g[:, None])
    kv = jnp.einsum('bnjhd,hj,bnjhe->bnhde', kc, zeta, vc)
    chunk_decay = jnp.exp(RET_CHUNK * log_g)[None, :, None, None]

    def step(s, kv_i):
        return chunk_decay * s + kv_i, s

    s_final, s_prev = lax.scan(step, s0.astype(f32), jnp.moveaxis(kv, 1, 0))
    xi = jnp.exp((idx + 1.0)[:, None] * log_g[None, :])
    cross = jnp.einsum('bnihd,nbhde->bnihe', qc, s_prev) * xi[None, None, :, :, None]
    out = (inner + cross).reshape(B, T, H, dv).astype(q.dtype)
    return out, s_final.astype(q.dtype)


def mla_attend(q_nope, q_rope, k_nope, k_rope, v):
    B, Tq, H, _ = q_nope.shape
    nb = Tq // Q_BLOCK
    scale = (MLA_D_NOPE + MLA_D_ROPE) ** -0.5

    def block(qs):
        qn, qr = qs
        s = jnp.einsum('bqhd,bkhd->bhqk', qn, k_nope) + jnp.einsum('bqhd,bkd->bhqk', qr, k_rope)
        p = jax.nn.softmax(s.astype(jnp.float32) * scale, axis=-1).astype(v.dtype)
        return jnp.einsum('bhqk,bkhd->bqhd', p, v)

    def to_blocks(t):
        return jnp.swapaxes(t.reshape(B, nb, Q_BLOCK, H, t.shape[-1]), 0, 1)

    out = lax.map(block, (to_blocks(q_nope), to_blocks(q_rope)))
    return jnp.swapaxes(out, 0, 1).reshape(B, Tq, H, v.shape[-1])


def token_mixer(u, lp, ctx, rope):
    B, T, _ = u.shape
    (glu_a, glu_g, r_q, r_k, r_v, r_g, m_q, m_kv, m_kr, br_g) = jnp.split(u @ lp['mix_w_in'], MIX_SPLITS, axis=-1)
    conv_out = conformer_conv(glu_a, glu_g, lp['conv_w_dw'], lp['conv_b_dw'], lp['conv_ln_g'],
                              lp['conv_ln_b'], lp['conv_w_out'])
    q = r_q.reshape(B, T, RET_HEADS, RET_DK)
    k = r_k.reshape(B, T, RET_HEADS, RET_DK) * (RET_DK ** -0.5)
    v = r_v.reshape(B, T, RET_HEADS, RET_DV)
    log_gf = jax.nn.log_sigmoid(lp['ret_decay_fwd'].astype(jnp.float32))
    log_gb = jax.nn.log_sigmoid(lp['ret_decay_bwd'].astype(jnp.float32))
    if ctx is None:
        s0f = jnp.zeros((B, RET_HEADS, RET_DK, RET_DV), jnp.float32)
        s0b = jnp.zeros((B, RET_HEADS, RET_DK, RET_DV), jnp.float32)
    else:
        s0f, s0b = ctx[2], ctx[3]
    o_f, s_f = retention_chunkwise(q, k, v, log_gf, s0f, False)
    o_b, s_b = retention_chunkwise(q[:, ::-1], k[:, ::-1], v[:, ::-1], log_gb, s0b, True)
    o = head_norm(o_f + o_b[:, ::-1]).reshape(B, T, RET_HEADS * RET_DV)
    ret_out = (jax.nn.silu(r_g) * o) @ lp['ret_w_out']
    q_m = (rms_norm(m_q, lp['mla_q_norm']) @ lp['mla_w_uq']).reshape(B, T, MLA_HEADS, MLA_D_NOPE + MLA_D_ROPE)
    q_nope, q_rope = q_m[..., :MLA_D_NOPE], q_m[..., MLA_D_NOPE:]
    c_kv = rms_norm(m_kv, lp['mla_kv_norm'])
    k_rope = m_kr
    if rope is not None:
        cos, sin = rope
        q_rope = apply_axial_rope(q_rope, cos[:, None], sin[:, None])
        k_rope = apply_axial_rope(k_rope, cos, sin)
    if ctx is None:
        ckv_all, kr_all = c_kv, k_rope
    else:
        ckv_all = jnp.concatenate([ctx[0], c_kv], axis=1)
        kr_all = jnp.concatenate([ctx[1], k_rope], axis=1)
    kv = (ckv_all @ lp['mla_w_ukv']).reshape(B, ckv_all.shape[1], MLA_HEADS, MLA_D_NOPE + MLA_D_V)
    attn = mla_attend(q_nope, q_rope, kv[..., :MLA_D_NOPE], kr_all, kv[..., MLA_D_NOPE:])
    mla_out = attn.reshape(B, T, MLA_HEADS * MLA_D_V) @ lp['mla_w_out']
    g = jax.nn.sigmoid(br_g).reshape(B, T, N_BRANCHES, D_MODEL)
    merged = g[..., 0, :] * conv_out + g[..., 1, :] * ret_out + g[..., 2, :] * mla_out
    out = merged @ lp['mix_w_o']
    new_ctx = (c_kv, k_rope, s_f, s_b) if ctx is None else None
    return out, new_ctx


def trunk_layer(x, cvec, lp, ctx, rope):
    mod = (jax.nn.silu(cvec) @ lp['ada_w'] + lp['ada_b']).reshape(cvec.shape[0], 1, N_MODS, D_MODEL)
    h = modulate(x, mod[:, :, 0], mod[:, :, 1])
    x = layer_norm(DEEPNORM_ALPHA * x + 0.5 * mod[:, :, 2] * swiglu(h, lp['ffn1_w_in'], lp['ffn1_w_out']),
                   lp['post_ln_g'][0], lp['post_ln_b'][0])
    m, new_ctx = token_mixer(modulate(x, mod[:, :, 3], mod[:, :, 4]), lp, ctx, rope)
    x = layer_norm(DEEPNORM_ALPHA * x + mod[:, :, 5] * m, lp['post_ln_g'][1], lp['post_ln_b'][1])
    h = modulate(x, mod[:, :, 6], mod[:, :, 7])
    x = layer_norm(DEEPNORM_ALPHA * x + 0.5 * mod[:, :, 8] * swiglu(h, lp['ffn2_w_in'], lp['ffn2_w_out']),
                   lp['post_ln_g'][2], lp['post_ln_b'][2])
    return x, new_ctx


def setup_inputs(seed: int = 0) -> dict:
    key = jax.random.key(seed)
    ks = iter(jax.random.split(key, 48))
    f32 = jnp.float32

    def nrm(shape, scale):
        return scale * jax.random.normal(next(ks), shape, f32)

    gammas = 1.0 - 2.0 ** (-5.0 - np.arange(RET_HEADS))
    decay_logit = jnp.asarray(np.log(gammas / (1.0 - gammas)), f32)
    gate_offset = jnp.tile(jnp.concatenate([jnp.zeros((2 * D_MODEL,), f32), jnp.ones((D_MODEL,), f32)]), 3)
    beta = DEEPNORM_BETA
    return {
        'x_prompt': nrm((BATCH, SEQ, D_MODEL), 1.0),
        'x_sample': nrm((DEC_BATCH, DEC_SEQ, D_MODEL), 1.0),
        'cache_mla_ckv': nrm((DEC_BATCH, DEPTH, PAST_LEN, MLA_KV_LORA), 1.0),
        'cache_mla_krope': nrm((DEC_BATCH, DEPTH, PAST_LEN, MLA_D_ROPE), 1.0),
        'state_ret_fwd': nrm((DEC_BATCH, DEPTH, RET_HEADS, RET_DK, RET_DV), 0.5),
        'state_ret_bwd': nrm((DEC_BATCH, DEPTH, RET_HEADS, RET_DK, RET_DV), 0.5),
        'c': nrm((DEC_BATCH, D_MODEL), 1.0),
        'c_ctx': nrm((D_MODEL,), 1.0),
        'ada_w': nrm((DEPTH, D_MODEL, N_MODS * D_MODEL), 0.5 * D_MODEL ** -0.5),
        'ada_b': gate_offset + nrm((DEPTH, N_MODS * D_MODEL), 0.02),
        'ffn1_w_in': nrm((DEPTH, D_MODEL, 2 * D_FF), D_MODEL ** -0.5),
        'ffn1_w_out': nrm((DEPTH, D_FF, D_MODEL), beta * D_FF ** -0.5),
        'ffn2_w_in': nrm((DEPTH, D_MODEL, 2 * D_FF), D_MODEL ** -0.5),
        'ffn2_w_out': nrm((DEPTH, D_FF, D_MODEL), beta * D_FF ** -0.5),
        'post_ln_g': 1.0 + nrm((DEPTH, 3, D_MODEL), 0.02),
        'post_ln_b': nrm((DEPTH, 3, D_MODEL), 0.02),
        'mix_w_in': nrm((DEPTH, D_MODEL, MIX_IN), D_MODEL ** -0.5),
        'conv_w_dw': nrm((DEPTH, CONV_WIDTH, CONV_DIM), CONV_WIDTH ** -0.5),
        'conv_b_dw': nrm((DEPTH, CONV_DIM), 0.02),
        'conv_ln_g': 1.0 + nrm((DEPTH, CONV_DIM), 0.02),
        'conv_ln_b': nrm((DEPTH, CONV_DIM), 0.02),
        'conv_w_out': nrm((DEPTH, CONV_DIM, D_MODEL), beta * CONV_DIM ** -0.5),
        'ret_decay_fwd': decay_logit[None] + nrm((DEPTH, RET_HEADS), 0.1),
        'ret_decay_bwd': decay_logit[None] + nrm((DEPTH, RET_HEADS), 0.1),
        'ret_w_out': nrm((DEPTH, RET_HEADS * RET_DV, D_MODEL), beta * (RET_HEADS * RET_DV) ** -0.5),
        'mla_q_norm': 1.0 + nrm((DEPTH, MLA_Q_LORA), 0.02),
        'mla_w_uq': nrm((DEPTH, MLA_Q_LORA, MLA_HEADS * (MLA_D_NOPE + MLA_D_ROPE)), MLA_Q_LORA ** -0.5),
        'mla_kv_norm': 1.0 + nrm((DEPTH, MLA_KV_LORA), 0.02),
        'mla_w_ukv': nrm((DEPTH, MLA_KV_LORA, MLA_HEADS * (MLA_D_NOPE + MLA_D_V)), MLA_KV_LORA ** -0.5),
        'mla_w_out': nrm((DEPTH, MLA_HEADS * MLA_D_V, D_MODEL), beta * (MLA_HEADS * MLA_D_V) ** -0.5),
        'mix_w_o': nrm((DEPTH, D_MODEL, D_MODEL), beta * D_MODEL ** -0.5),
    }


def reference(x_prompt, x_sample, cache_mla_ckv, cache_mla_krope, state_ret_fwd, state_ret_bwd, c, c_ctx,
              ada_w, ada_b, ffn1_w_in, ffn1_w_out, ffn2_w_in, ffn2_w_out, post_ln_g, post_ln_b,
              mix_w_in, conv_w_dw, conv_b_dw, conv_ln_g, conv_ln_b, conv_w_out,
              ret_decay_fwd, ret_decay_bwd, ret_w_out,
              mla_q_norm, mla_w_uq, mla_kv_norm, mla_w_ukv, mla_w_out, mix_w_o):
    rope = axial_rope_tables(x_sample.shape[1], x_sample.dtype)
    h_ctx = x_prompt
    h_lat = x_sample
    c_ctx_row = c_ctx[None, :]
    ckv_l, kr_l, sf_l, sb_l = [], [], [], []
    for l in range(DEPTH):
        lp = {
            'ada_w': ada_w[l], 'ada_b': ada_b[l],
            'ffn1_w_in': ffn1_w_in[l], 'ffn1_w_out': ffn1_w_out[l],
            'ffn2_w_in': ffn2_w_in[l], 'ffn2_w_out': ffn2_w_out[l],
            'post_ln_g': post_ln_g[l], 'post_ln_b': post_ln_b[l],
            'mix_w_in': mix_w_in[l], 'conv_w_dw': conv_w_dw[l], 'conv_b_dw': conv_b_dw[l],
            'conv_ln_g': conv_ln_g[l], 'conv_ln_b': conv_ln_b[l], 'conv_w_out': conv_w_out[l],
            'ret_decay_fwd': ret_decay_fwd[l], 'ret_decay_bwd': ret_decay_bwd[l], 'ret_w_out': ret_w_out[l],
            'mla_q_norm': mla_q_norm[l], 'mla_w_uq': mla_w_uq[l], 'mla_kv_norm': mla_kv_norm[l],
            'mla_w_ukv': mla_w_ukv[l], 'mla_w_out': mla_w_out[l], 'mix_w_o': mix_w_o[l],
        }
        h_ctx, (ckv, kr, sf, sb) = trunk_layer(h_ctx, c_ctx_row, lp, None, None)
        ckv_l.append(ckv)
        kr_l.append(kr)
        sf_l.append(sf)
        sb_l.append(sb)
        ctx = (cache_mla_ckv[:, l], cache_mla_krope[:, l], state_ret_fwd[:, l], state_ret_bwd[:, l])
        h_lat, _ = trunk_layer(h_lat, c, lp, ctx, rope)
    return (h_ctx, h_lat, jnp.stack(ckv_l, axis=1), jnp.stack(kr_l, axis=1),
            jnp.stack(sf_l, axis=1), jnp.stack(sb_l, axis=1))
```

```cpp
#include <hip/hip_runtime.h>
#include <hip/hip_cooperative_groups.h>
#include <cstdio>
namespace cg = cooperative_groups;

#ifndef MK_PER_PHASE
#define MK_PER_PHASE 0
#endif
#ifndef MK_DBG_SPAN
#define MK_DBG_SPAN 1
#endif
#ifndef MK_REPEAT_MASK
#define MK_REPEAT_MASK 0
#endif
#ifndef MK_PH_HI
#define MK_PH_HI 26
#endif

#define LAS __attribute__((address_space(3)))
typedef unsigned short bf16_t;
typedef short bf16x8 __attribute__((ext_vector_type(8)));
typedef float f32x4 __attribute__((ext_vector_type(4)));
typedef unsigned u32x4 __attribute__((ext_vector_type(4)));
typedef unsigned u32x2 __attribute__((ext_vector_type(2)));

constexpr int NTOK = 8192;
constexpr float ALPHA = 1.41421356237f;
constexpr float QSCALE = 0.10206207261f * 1.44269504089f;
constexpr int N_PHASES = 26;

constexpr size_t OUT_CKV = 8388608, OUT_KROPE = 10485760, OUT_RF = 10747904, OUT_RB = 14942208;

constexpr size_t MBy = 1u << 20;
constexpr size_t W_FFN1_IN = 0, W_FFN1_OUT = 11534336, W_FFN2_IN = 17301504, W_FFN2_OUT = 28835840, W_MIX_IN = 34603008,
                 W_M2 = 51380224, W_BR = 55705600, W_O2 = 59899904;
constexpr size_t WS_MOD = 62 * MBy, WS_SSQQ = 62 * MBy + 512 * 1024, WS_SSQKV = 62 * MBy + 768 * 1024;
constexpr size_t WS_BAR = 62 * MBy + 960 * 1024;
constexpr size_t WS_Z1 = 63 * MBy, WS_ACT = WS_Z1, WS_H = WS_Z1 + 48 * MBy, WS_KVT = WS_Z1;
constexpr size_t WS_Z2 = 127 * MBy, WS_F = WS_Z2, WS_BR = WS_Z2, WS_SCR = WS_Z2 + 32 * MBy, WS_Q = WS_Z2 + 32 * MBy,
                 WS_KN = WS_Z2 + 45 * MBy, WS_VT = WS_Z2 + 54 * MBy, WS_KROPE = WS_Z2 + 63 * MBy;
constexpr size_t WS_Z3 = 191 * MBy, WS_HGLU = WS_Z3, WS_QR = WS_Z3 + 8 * MBy, WS_KR = WS_Z3 + 16 * MBy, WS_KRT = WS_Z3 + 24 * MBy,
                 WS_VRT = WS_Z3 + 32 * MBy, WS_GR = WS_Z3 + 48 * MBy, WS_MQKV = WS_Z3 + 64 * MBy, WS_MG = WS_Z3;
constexpr size_t WS_BG = 269 * MBy, WS_S0T = 317 * MBy, WS_END = 321 * MBy;

struct Args {
    const float* in[31];
    float* out;
    unsigned char* ws;
    int ph_lo, ph_hi;
};
enum { I_XP = 0, I_XS, I_CKV, I_CKR, I_SF, I_SB, I_C, I_CCTX, I_ADAW, I_ADAB, I_F1IN, I_F1OUT, I_F2IN, I_F2OUT, I_LNG, I_LNB, I_MIXIN,
       I_CWDW, I_CBDW, I_CLNG, I_CLNB, I_CWOUT, I_RDF, I_RDB, I_RWOUT, I_QNORM, I_WUQ, I_KVNORM, I_WUKV, I_MWOUT, I_WO };

typedef float f32x2_t __attribute__((ext_vector_type(2)));
typedef __bf16 bf16x2_t __attribute__((ext_vector_type(2)));
__device__ __forceinline__ unsigned cvt_pk_bf16(float lo, float hi) { const f32x2_t v = {lo, hi}; return __builtin_bit_cast(unsigned, __builtin_convertvector(v, bf16x2_t)); }
__device__ __forceinline__ bf16_t f2bf(float x) { return (bf16_t)(cvt_pk_bf16(x, 0.f) & 0xffffu); }
__device__ __forceinline__ float bflo(unsigned w) { return __uint_as_float(w << 16); }
__device__ __forceinline__ float bfhi(unsigned w) { return __uint_as_float(w & 0xffff0000u); }
__device__ __forceinline__ float sigm(float x) { return __builtin_amdgcn_rcpf(1.0f + __expf(-x)); }
__device__ __forceinline__ float silu(float x) { return x * sigm(x); }
__device__ __forceinline__ float wave_sum(float v) {
#pragma unroll
    for (int o = 32; o >= 1; o >>= 1) v += __shfl_xor(v, o);
    return v;
}
__device__ __forceinline__ u32x2 pack4(f32x4 v) { u32x2 w; w.x = cvt_pk_bf16(v[0], v[1]); w.y = cvt_pk_bf16(v[2], v[3]); return w; }
__device__ __forceinline__ f32x4 unpack4(u32x2 w) { return (f32x4){bflo(w.x), bfhi(w.x), bflo(w.y), bfhi(w.y)}; }
union FragU { u32x4 u; bf16x8 v; };
__device__ __forceinline__ u32x4 pack8(f32x4 a, f32x4 b) { u32x4 w; w.x = cvt_pk_bf16(a[0], a[1]); w.y = cvt_pk_bf16(a[2], a[3]); w.z = cvt_pk_bf16(b[0], b[1]); w.w = cvt_pk_bf16(b[2], b[3]); return w; }
__device__ __forceinline__ int perm32(int rho) { const int n = rho >> 4, i = rho & 15; return 8 * (i >> 2) + 4 * n + (i & 3); }
__device__ __forceinline__ bf16x8 ldfrag(const bf16_t* p) { return *(const bf16x8*)p; }
#define MFMA16(a, b, c) __builtin_amdgcn_mfma_f32_16x16x32_bf16((a), (b), (c), 0, 0, 0)

__device__ __forceinline__ int otid() { int t = threadIdx.x; asm volatile("" : "+v"(t)); return t; }
struct Ctx {
    unsigned char* ws; float* out;
#define CXP(name, type, off) __device__ __forceinline__ type* name() const { return (type*)(ws + (off)); }
    CXP(MOD, float, WS_MOD) CXP(SSQQ, float, WS_SSQQ) CXP(SSQKV, float, WS_SSQKV) CXP(ACT, bf16_t, WS_ACT) CXP(H, bf16_t, WS_H) CXP(KVT, float, WS_KVT)
    CXP(F, float, WS_F) CXP(BR, bf16_t, WS_BR) CXP(SCR, float, WS_SCR) CXP(Q, bf16_t, WS_Q) CXP(HGLU, bf16_t, WS_HGLU) CXP(QR, bf16_t, WS_QR)
    CXP(KR, bf16_t, WS_KR) CXP(KRT, bf16_t, WS_KRT) CXP(VRT, bf16_t, WS_VRT) CXP(GR, bf16_t, WS_GR) CXP(MQKV, bf16_t, WS_MQKV) CXP(MG, bf16_t, WS_MG)
    CXP(BG, bf16_t, WS_BG) CXP(KN, bf16_t, WS_KN) CXP(VT, bf16_t, WS_VT) CXP(KROPE, bf16_t, WS_KROPE) CXP(S0T, float, WS_S0T)
#undef CXP
};

constexpr int BM = 256, BK = 64, HALF = 128, HTB = HALF * BK * 2, STAGE_BYTES = 8 * HTB;
constexpr int RS_OFF = STAGE_BYTES + 16;
__device__ __forceinline__ int lds_byte(int r, int c) { const int st = (r >> 4) * 2 + (c >> 5), rr = r & 15, cc = c & 31, ob = rr * 64 + cc * 2; return st * 1024 + (ob ^ (((ob >> 9) & 1) << 5)); }
__device__ __forceinline__ void stage_rc(int b, int& R, int& C) { const int st = b / 1024, sb = b % 1024, swz = sb ^ (((sb >> 9) & 1) << 5); R = (st >> 1) * 16 + swz / 64; C = (st & 1) * 32 + (swz % 64) / 2; }

enum { GT_FFN_IN = 0, GT_FFN_OUT, GT_MIX_IN, GT_M2, GT_BR, GT_MIX_O };
enum { EK_SWIGLU = 0, EK_F32, EK_MIXIN, EK_QUP, EK_KVUP, EK_KVC, EK_BR0, EK_BR1, EK_BR2 };
struct Unit { size_t aoff, boff; int nt, kind, pm, pn, kz; };
struct GemmCall { const char* A; const char* Bt; unsigned ld2; int gt; };

__device__ __forceinline__ void tile_order(int L, int nM, int nN, int& pm, int& pn) {
    const int nwg = nM * nN; int wgid = L;
    { const int q = nwg / 8, r = nwg % 8, xcd = wgid % 8, off = wgid / 8; wgid = (xcd < r ? xcd * (q + 1) : r * (q + 1) + (xcd - r) * q) + off; }
    const int nig = 8 * nN, gid = wgid / nig, fm = gid * 8, gsz = (nM - fm) < 8 ? (nM - fm) : 8;
    pm = fm + ((wgid % nig) % gsz); pn = (wgid % nig) / gsz;
}

__device__ __forceinline__ bool sched_next(const GemmCall& g, int i, int c, int G, Unit& u) {
    const int L = i * G + c;
    u.kz = 0;
    switch (g.gt) {
    case GT_FFN_IN: {
        if (L >= 32 * 22) return false;
        int pm, pn; tile_order(L, 32, 22, pm, pn);
        u.pm = pm; u.pn = pn; u.nt = 16; u.kind = EK_SWIGLU; u.aoff = (size_t)pm * 256 * g.ld2; u.boff = (size_t)pn * 256 * g.ld2; return true; }
    case GT_FFN_OUT: {
        if (L >= 256) return false;
        int pm, pe; tile_order(L, 32, 8, pm, pe);
        u.pm = pm; u.pn = pe >> 1; u.kz = pe & 1; u.nt = 22; u.kind = EK_F32;
        u.aoff = (size_t)pm * 256 * g.ld2 + (size_t)u.kz * 1408 * 2; u.boff = (size_t)u.pn * 256 * g.ld2 + (size_t)u.kz * 1408 * 2; return true; }
    case GT_MIX_IN: {
        if (L >= 1024) return false;
        int pm, pn; tile_order(L, 32, 32, pm, pn);
        u.pm = pm; u.pn = pn; u.nt = 16; u.kind = EK_MIXIN; u.aoff = (size_t)pm * 256 * g.ld2; u.boff = (size_t)pn * 256 * g.ld2; return true; }
    case GT_M2: {
        if (L >= 240) return false;
        if (L < 96) { u.pm = L & 31; u.pn = L >> 5; u.nt = 8; u.kind = EK_QUP; u.aoff = (size_t)u.pm * 256 * g.ld2; u.boff = (size_t)u.pn * 256 * g.ld2; }
        else if (L < 224) { const int t = L - 96; u.pm = t & 31; u.pn = t >> 5; u.nt = 4; u.kind = EK_KVUP; u.aoff = (size_t)u.pm * 256 * g.ld2 + 512 * 2; u.boff = (size_t)(768 + u.pn * 256) * g.ld2; }
        else { const int t = L - 224; u.pm = t & 3; u.pn = t >> 2; u.nt = 4; u.kind = EK_KVC; u.aoff = (size_t)(8192 + u.pm * 256) * g.ld2 + 512 * 2; u.boff = (size_t)(1792 + u.pn * 256) * g.ld2; }
        return true; }
    case GT_BR: {
        int rem = i, slot = -1;
        for (int j = 0;; ++j) { const int sl = j * G + c; if (sl >= 256) return false; const int n = sl < 128 ? 1 : 2; if (rem < n) { slot = sl; break; } rem -= n; }
        if (slot < 128) { u.pm = slot & 31; u.pn = slot >> 5; u.nt = 16; u.kind = EK_BR1; u.aoff = (size_t)u.pm * 256 * g.ld2; u.boff = (size_t)u.pn * 256 * g.ld2; return true; }
        { const int t = slot - 128; u.pm = t & 31; u.pn = t >> 5; u.nt = 8; const int koff = (rem == 0) ? 1024 : 1536; u.kind = (rem == 0) ? EK_BR0 : EK_BR2;
          u.aoff = (size_t)u.pm * 256 * g.ld2 + (size_t)koff * 2; u.boff = (size_t)u.pn * 256 * g.ld2 + (size_t)koff * 2; }
        return true; }
    default: {
        if (L >= 256) return false;
        int pm, pe; tile_order(L, 32, 8, pm, pe);
        u.pm = pm; u.pn = pe >> 1; u.kz = pe & 1; u.nt = 16; u.kind = EK_F32;
        u.aoff = (size_t)pm * 256 * g.ld2 + (size_t)u.kz * 1024 * 2; u.boff = (size_t)u.pn * 256 * g.ld2 + (size_t)u.kz * 1024 * 2; return true; }
    }
}

__device__ __forceinline__ void rope4(f32x4& x1, f32x4& x2, int t, int fq) {
    const float pos = (float)((fq >> 1) ? (t & 63) : (t >> 6));
#pragma unroll
    for (int j = 0; j < 4; ++j) {
        const float fi = (float)(4 * (fq & 1) + j);
        const float ang = pos * exp2f(-fi * 1.6609640474f);
        const float cs = __cosf(ang), sn = __sinf(ang);
        const float a = x1[j], b = x2[j];
        x1[j] = a * cs - b * sn; x2[j] = a * sn + b * cs;
    }
}

__device__ __forceinline__ void epilogue(const Ctx& cx, const Args& a, int l, const f32x4 (&acc)[2][2][4][2], const Unit& u, LAS unsigned char* lds) {
    const int tid_e = otid(), wid_e = __builtin_amdgcn_readfirstlane(tid_e >> 6), wr = wid_e >> 2, wc = wid_e & 3, fr = tid_e & 15, fq = (tid_e & 63) >> 4;
    const int row0 = u.pm * 256 + wr * 64 + fr;
    const int cin0 = wc * 32 + 4 * fq;
    const int cP = wc * 32 + 8 * fq;
    switch (u.kind) {
    case EK_SWIGLU: {
#pragma unroll
        for (int ai = 0; ai < 2; ++ai)
#pragma unroll
            for (int m = 0; m < 4; ++m) {
                const int r = row0 + ai * 128 + m * 16;
                bf16_t* rowp = cx.ACT() + (size_t)r * 2816 + u.pn * 128 + cP;
                f32x4 v[2];
#pragma unroll
                for (int n = 0; n < 2; ++n) {
                    const f32x4 g = acc[ai][0][m][n], up = acc[ai][1][m][n];
#pragma unroll
                    for (int j = 0; j < 4; ++j) v[n][j] = silu(g[j]) * up[j];
                }
                *(u32x4*)rowp = pack8(v[0], v[1]);
            }
    } break;
    case EK_F32: {
#pragma unroll
        for (int ai = 0; ai < 2; ++ai)
#pragma unroll
            for (int m = 0; m < 4; ++m) {
                const int r = row0 + ai * 128 + m * 16;
                bf16_t* rowp = (bf16_t*)cx.F() + ((size_t)u.kz * NTOK + r) * 1024 + u.pn * 256 + cP;
#pragma unroll
                for (int bj = 0; bj < 2; ++bj) *(u32x4*)(rowp + bj * 128) = pack8(acc[ai][bj][m][0], acc[ai][bj][m][1]);
            }
    } break;
    case EK_MIXIN: {
        const int pn = u.pn;
        const int rowbase = (u.pm < 16) ? u.pm * 256 : 4096 + ((u.pm - 16) >> 2) * 1024;
        const int T = (u.pm < 16) ? 256 : 1024;
        if (pn < 4) {
#pragma unroll
            for (int ai = 0; ai < 2; ++ai)
#pragma unroll
                for (int m = 0; m < 4; ++m) {
                    const int r = row0 + ai * 128 + m * 16;
                    bf16_t* rowp = cx.HGLU() + (size_t)r * 512 + pn * 128 + cP;
                    f32x4 v[2];
#pragma unroll
                    for (int n = 0; n < 2; ++n) {
                        const f32x4 av = acc[ai][0][m][n], g = acc[ai][1][m][n];
#pragma unroll
                        for (int j = 0; j < 4; ++j) v[n][j] = av[j] * sigm(g[j]);
                    }
                    *(u32x4*)rowp = pack8(v[0], v[1]);
                }
        } else if (pn < 6) {
#pragma unroll
            for (int ai = 0; ai < 2; ++ai)
#pragma unroll
                for (int m = 0; m < 4; ++m) {
                    const int r = row0 + ai * 128 + m * 16;
                    bf16_t* rowp = cx.QR() + (size_t)r * 512 + (pn - 4) * 256 + cP;
#pragma unroll
                    for (int bj = 0; bj < 2; ++bj) *(u32x4*)(rowp + bj * 128) = pack8(acc[ai][bj][m][0], acc[ai][bj][m][1]);
                }
        } else if (pn < 8) {
            bf16_t* tb = cx.KRT() + (size_t)rowbase * 512;
#pragma unroll
            for (int ai = 0; ai < 2; ++ai)
#pragma unroll
                for (int m = 0; m < 4; ++m) {
                    const int r = row0 + ai * 128 + m * 16;
                    bf16_t* rowp = cx.KR() + (size_t)r * 512 + (pn - 6) * 256 + cin0;
#pragma unroll
                    for (int bj = 0; bj < 2; ++bj)
#pragma unroll
                        for (int n = 0; n < 2; ++n) {
                            const f32x4 v = acc[ai][bj][m][n] * 0.08838834764f;
                            const u32x2 w = pack4(v);
                            *(u32x2*)(rowp + bj * 128 + n * 16) = w;
                            const int col = (pn - 6) * 256 + bj * 128 + n * 16 + cin0;
                            bf16_t* tp = tb + (size_t)col * T + (r - rowbase);
                            tp[0] = (bf16_t)(w.x & 0xffffu); tp[(size_t)T] = (bf16_t)(w.x >> 16); tp[(size_t)2 * T] = (bf16_t)(w.y & 0xffffu); tp[(size_t)3 * T] = (bf16_t)(w.y >> 16);
                        }
                }
        } else if (pn < 12) {
            bf16_t* tb = cx.VRT() + (size_t)rowbase * 1024;
#pragma unroll
            for (int ai = 0; ai < 2; ++ai)
#pragma unroll
                for (int m = 0; m < 4; ++m) {
                    const int r = row0 + ai * 128 + m * 16;
#pragma unroll
                    for (int bj = 0; bj < 2; ++bj)
#pragma unroll
                        for (int n = 0; n < 2; ++n) {
                            const u32x2 w = pack4(acc[ai][bj][m][n]);
                            const int col = (pn - 8) * 256 + bj * 128 + n * 16 + cin0;
                            bf16_t* tp = tb + (size_t)col * T + (r - rowbase);
                            tp[0] = (bf16_t)(w.x & 0xffffu); tp[(size_t)T] = (bf16_t)(w.x >> 16); tp[(size_t)2 * T] = (bf16_t)(w.y & 0xffffu); tp[(size_t)3 * T] = (bf16_t)(w.y >> 16);
                        }
                }
        } else if (pn < 16) {
#pragma unroll
            for (int ai = 0; ai < 2; ++ai)
#pragma unroll
                for (int m = 0; m < 4; ++m) {
                    const int r = row0 + ai * 128 + m * 16;
                    bf16_t* rowp = cx.GR() + (size_t)r * 1024 + (pn - 12) * 256 + cP;
#pragma unroll
                    for (int bj = 0; bj < 2; ++bj) { f32x4 v[2];
#pragma unroll
                        for (int n = 0; n < 2; ++n) { const f32x4 x = acc[ai][bj][m][n];
#pragma unroll
                            for (int j = 0; j < 4; ++j) v[n][j] = silu(x[j]); }
                        *(u32x4*)(rowp + bj * 128) = pack8(v[0], v[1]); }
                }
        } else if (pn < 19) {
            const bool isq = pn < 18;
#pragma unroll
            for (int ai = 0; ai < 2; ++ai)
#pragma unroll
                for (int m = 0; m < 4; ++m) {
                    const int r = row0 + ai * 128 + m * 16;
                    bf16_t* rowp = cx.MQKV() + (size_t)r * 768 + (pn - 16) * 256 + cin0;
                    float s = 0.f;
#pragma unroll
                    for (int bj = 0; bj < 2; ++bj)
#pragma unroll
                        for (int n = 0; n < 2; ++n) { const f32x4 x = acc[ai][bj][m][n]; s += (x[0] * x[0] + x[1] * x[1]) + (x[2] * x[2] + x[3] * x[3]);
                            *(u32x2*)(rowp + bj * 128 + n * 16) = pack4(x); }
                    s += __shfl_xor(s, 16); s += __shfl_xor(s, 32);
                    if (fq == 0) { if (isq) cx.SSQQ()[(size_t)r * 8 + (pn - 16) * 4 + wc] = s; else cx.SSQKV()[(size_t)r * 4 + wc] = s; }
                    if (!isq && r < 4096) {
                        float* o = cx.out + OUT_CKV + ((size_t)((r >> 8) * 2 + l) * 256 + (r & 255)) * 256 + cin0;
#pragma unroll
                        for (int bj = 0; bj < 2; ++bj)
#pragma unroll
                            for (int n = 0; n < 2; ++n) *(f32x4*)(o + bj * 128 + n * 16) = acc[ai][bj][m][n];
                    }
                }
        } else if (pn == 19) {
            if (wc == 0) {
#pragma unroll
                for (int ai = 0; ai < 2; ++ai)
#pragma unroll
                    for (int m = 0; m < 4; ++m) {
                        const int r = row0 + ai * 128 + m * 16;
                        f32x4 x1 = acc[ai][0][m][0], x2 = acc[ai][0][m][1];
                        size_t kr;
                        if (r < 4096) {
                            float* o = cx.out + OUT_KROPE + ((size_t)((r >> 8) * 2 + l) * 256 + (r & 255)) * 32 + (fq >> 1) * 16 + 4 * (fq & 1);
                            *(f32x4*)(o) = x1; *(f32x4*)(o + 8) = x2;
                            kr = (size_t)r;
                        } else {
                            const int rr = r - 4096, t = rr & 1023;
                            rope4(x1, x2, t, fq);
                            kr = (size_t)4096 + (size_t)(rr >> 10) * 1280 + 256 + t;
                        }
                        bf16_t* kp = cx.KROPE() + kr * 32 + 4 * fq;
                        *(u32x2*)(kp) = pack4(x1); *(u32x2*)(kp + 16) = pack4(x2);
                    }
            }
        } else {
#pragma unroll
            for (int ai = 0; ai < 2; ++ai)
#pragma unroll
                for (int m = 0; m < 4; ++m) {
                    const int r = row0 + ai * 128 + m * 16;
                    bf16_t* rowp = cx.BG() + (size_t)r * 3072 + (pn - 20) * 256 + cP;
#pragma unroll
                    for (int bj = 0; bj < 2; ++bj) { f32x4 v[2];
#pragma unroll
                        for (int n = 0; n < 2; ++n) { const f32x4 x = acc[ai][bj][m][n];
#pragma unroll
                            for (int j = 0; j < 4; ++j) v[n][j] = sigm(x[j]); }
                        *(u32x4*)(rowp + bj * 128) = pack8(v[0], v[1]); }
                }
        }
    } break;
    case EK_QUP: {
#pragma unroll
        for (int ai = 0; ai < 2; ++ai)
#pragma unroll
            for (int m = 0; m < 4; ++m) {
                const int r = row0 + ai * 128 + m * 16;
                float rs;
                if (gridDim.x >= 240) rs = *(const LAS float*)(lds + RS_OFF + 4 * (wr * 64 + fr + ai * 128 + m * 16));
                else { const f32x4 s0 = *(const f32x4*)(cx.SSQQ() + (size_t)r * 8), s1 = *(const f32x4*)(cx.SSQQ() + (size_t)r * 8 + 4);
                       rs = rsqrtf((((s0[0] + s0[1]) + (s0[2] + s0[3])) + ((s1[0] + s1[1]) + (s1[2] + s1[3]))) * (1.0f / 512.0f) + 1e-6f) * QSCALE; }
                bf16_t* qrow = cx.Q() + (size_t)r * 768;
                if (u.pn < 2) {
#pragma unroll
                    for (int bj = 0; bj < 2; ++bj)
#pragma unroll
                        for (int n = 0; n < 2; ++n) {
                            const int col = u.pn * 256 + bj * 128 + n * 16 + cin0;
                            *(u32x2*)(qrow + (col >> 6) * 96 + (col & 63)) = pack4(acc[ai][bj][m][n] * rs);
                        }
                } else {
#pragma unroll
                    for (int bj = 0; bj < 2; ++bj) {
                        f32x4 x1 = acc[ai][bj][m][0] * rs, x2 = acc[ai][bj][m][1] * rs;
                        if (r >= 4096) rope4(x1, x2, (r - 4096) & 1023, fq);
                        bf16_t* qp = qrow + (4 * bj + wc) * 96 + 64 + 4 * fq;
                        *(u32x2*)(qp) = pack4(x1); *(u32x2*)(qp + 16) = pack4(x2);
                    }
                }
            }
    } break;
    case EK_KVUP:
    case EK_KVC: {
        const bool cache = (u.kind == EK_KVC);
        int kbase, Tk, joff;
        if (cache) { kbase = 4096 + 1280 * u.pm; Tk = 1280; joff = 0; }
        else if (u.pm < 16) { kbase = 256 * u.pm; Tk = 256; joff = 0; }
        else { const int b = (u.pm - 16) >> 2; kbase = 4096 + 1280 * b; Tk = 1280; joff = 256 + ((u.pm - 16) & 3) * 256; }
#pragma unroll
        for (int ai = 0; ai < 2; ++ai)
#pragma unroll
            for (int m = 0; m < 4; ++m) {
                const int lr_ = wr * 64 + fr + ai * 128 + m * 16;
                const int r = u.pm * 256 + lr_;
                float rs = 1.0f;
                if (!cache) {
                    if (gridDim.x >= 240) rs = *(const LAS float*)(lds + RS_OFF + 4 * lr_);
                    else { const f32x4 s0 = *(const f32x4*)(cx.SSQKV() + (size_t)r * 4); rs = rsqrtf(((s0[0] + s0[1]) + (s0[2] + s0[3])) * (1.0f / 256.0f) + 1e-6f); }
                }
                const int jpos = joff + lr_;
#pragma unroll
                for (int bj = 0; bj < 2; ++bj) {
                    const int head = 2 * u.pn + bj;
#pragma unroll
                    for (int n = 0; n < 2; ++n) {
                        const u32x2 w = pack4(acc[ai][bj][m][n] * rs);
                        if (wc < 2) {
                            *(u32x2*)(cx.KN() + (size_t)(kbase + jpos) * 512 + head * 64 + wc * 32 + n * 16 + 4 * fq) = w;
                        } else {
                            const int dv = (wc - 2) * 32 + n * 16 + 4 * fq;
                            bf16_t* tp = cx.VT() + (size_t)kbase * 512 + (size_t)(head * 64 + dv) * Tk + jpos;
                            tp[0] = (bf16_t)(w.x & 0xffffu); tp[(size_t)Tk] = (bf16_t)(w.x >> 16); tp[(size_t)2 * Tk] = (bf16_t)(w.y & 0xffffu); tp[(size_t)3 * Tk] = (bf16_t)(w.y >> 16);
                        }
                    }
                }
            }
    } break;
    case EK_BR0:
    case EK_BR1:
    case EK_BR2: {
        const int gofs = (u.kind == EK_BR0) ? 0 : (u.kind == EK_BR1 ? 1024 : 2048);
        __builtin_assume_separate_storage(cx.BG(), cx.MG()); __builtin_assume_separate_storage(cx.BG(), cx.SCR()); __builtin_assume_separate_storage(cx.SCR(), cx.MG());
#pragma unroll
        for (int ai = 0; ai < 2; ++ai)
#pragma unroll
            for (int m = 0; m < 4; ++m) {
                const int r = row0 + ai * 128 + m * 16;
                const int colb = u.pn * 256 + cP;
                u32x4 gw[2]; u32x4 sv[2];
#pragma unroll
                for (int bj = 0; bj < 2; ++bj) {
                    gw[bj] = *(const u32x4*)(cx.BG() + (size_t)r * 3072 + gofs + colb + bj * 128);
                    if (u.kind == EK_BR2) sv[bj] = *(const u32x4*)((const bf16_t*)cx.SCR() + (size_t)r * 1024 + colb + bj * 128);
                }
#pragma unroll
                for (int bj = 0; bj < 2; ++bj) {
                    const int col = colb + bj * 128;
                    const f32x4 g0 = (f32x4){bflo(gw[bj].x), bfhi(gw[bj].x), bflo(gw[bj].y), bfhi(gw[bj].y)}, g1 = (f32x4){bflo(gw[bj].z), bfhi(gw[bj].z), bflo(gw[bj].w), bfhi(gw[bj].w)};
                    f32x4 v0 = acc[ai][bj][m][0] * g0, v1 = acc[ai][bj][m][1] * g1;
                    if (u.kind == EK_BR0) { *(u32x4*)((bf16_t*)cx.SCR() + (size_t)r * 1024 + col) = pack8(v0, v1); }
                    else if (u.kind == EK_BR1) { *(u32x4*)(cx.MG() + (size_t)r * 2048 + col) = pack8(v0, v1); }
                    else { v0 += (f32x4){bflo(sv[bj].x), bfhi(sv[bj].x), bflo(sv[bj].y), bfhi(sv[bj].y)}; v1 += (f32x4){bflo(sv[bj].z), bfhi(sv[bj].z), bflo(sv[bj].w), bfhi(sv[bj].w)}; *(u32x4*)(cx.MG() + (size_t)r * 2048 + 1024 + col) = pack8(v0, v1); }
                }
            }
    } break;
    default: break;
    }
}

__device__ __forceinline__ void gemm_phase(LAS unsigned char* lds, const GemmCall g, const Ctx& cx, const Args& a, int l) {
    const int tid = otid(), wid = __builtin_amdgcn_readfirstlane(tid >> 6), lane = tid & 63, wr = wid >> 2, wc = wid & 3, fr = lane & 15, fq = lane >> 4;
    const int G = gridDim.x, cidx = blockIdx.x;
    unsigned voffA[2];
#pragma unroll
    for (int i = 0; i < 2; ++i) { int R, C; stage_rc(tid * 16 + i * 8192, R, C); voffA[i] = (unsigned)R * g.ld2 + (unsigned)C * 2u; }
    const size_t kstep = (size_t)(BK * 2);
    const size_t hstepA = (size_t)HALF * g.ld2;
    const unsigned ldsw = (unsigned)wid * 1024u;
    const int aoff = lds_byte(wr * 64 + fr, fq * 8), boff = lds_byte(wc * 32 + fr, fq * 8);
#define PG8_SA(b, h) (((b) * 2 + (h)) * HTB)
#define PG8_SB(b, h) ((4 + (b) * 2 + (h)) * HTB)
#define PG8_STAGE(bufoff, gbase, voff) do { _Pragma("unroll") for (int _i = 0; _i < 2; ++_i) \
        __builtin_amdgcn_global_load_lds((const unsigned*)((const char*)(gbase) + (voff)[_i]), (LAS unsigned*)(lds + (bufoff) + ldsw + _i * 8192), 16, 0, 0); } while (0)
#define PG8_LDA(dst, b, h) do { _Pragma("unroll") for (int m = 0; m < 4; ++m) _Pragma("unroll") for (int k = 0; k < 2; ++k) dst[m][k] = *(const LAS bf16x8*)(lds + PG8_SA(b, h) + aoff + m * 2048 + k * 1024); } while (0)
#define PG8_LDB(dst, b, h) do { _Pragma("unroll") for (int n = 0; n < 2; ++n) _Pragma("unroll") for (int k = 0; k < 2; ++k) dst[n][k] = *(const LAS bf16x8*)(lds + PG8_SB(b, h) + boff + n * 2048 + k * 1024); } while (0)
#define PG8_MMA(ai, bj, At, Bt) do { __builtin_amdgcn_s_setprio(1); _Pragma("unroll") for (int m = 0; m < 4; ++m) _Pragma("unroll") for (int n = 0; n < 2; ++n) _Pragma("unroll") for (int k = 0; k < 2; ++k) \
        acc[ai][bj][m][n] = __builtin_amdgcn_mfma_f32_16x16x32_bf16(Bt[n][k], At[m][k], acc[ai][bj][m][n], 0, 0, 0); __builtin_amdgcn_s_setprio(0); } while (0)
#define PG8_WAIT_V(n) asm volatile("s_waitcnt vmcnt(" #n ")" ::: "memory")
#define PG8_WAIT_L(n) asm volatile("s_waitcnt lgkmcnt(" #n ")" ::: "memory")
#define PG8_BAR __builtin_amdgcn_s_barrier()
#define PG8_SCHED __builtin_amdgcn_sched_barrier(0)
    Unit cur, nxt; int ui = 0;
    if (!sched_next(g, 0, cidx, G, cur)) return;
    f32x4 acc[2][2][4][2];
#pragma unroll
    for (int x = 0; x < 2; ++x)
#pragma unroll
        for (int b = 0; b < 2; ++b)
#pragma unroll
            for (int m = 0; m < 4; ++m)
#pragma unroll
                for (int n = 0; n < 2; ++n) acc[x][b][m][n] = (f32x4){0.f, 0.f, 0.f, 0.f};
    bf16x8 At[4][2], B0[2][2], B1[2][2];
    const char* cA = g.A + cur.aoff; const char* cB = g.Bt + cur.boff;
    PG8_STAGE(PG8_SB(0, 0), cB, voffA); PG8_STAGE(PG8_SA(0, 0), cA, voffA); PG8_STAGE(PG8_SB(0, 1), cB + hstepA, voffA); PG8_STAGE(PG8_SA(0, 1), cA + hstepA, voffA);
    if (wr == 1) PG8_BAR;
    PG8_WAIT_V(4); PG8_BAR;
    PG8_STAGE(PG8_SB(1, 0), cB + kstep, voffA); PG8_STAGE(PG8_SA(1, 0), cA + kstep, voffA); PG8_STAGE(PG8_SB(1, 1), cB + hstepA + kstep, voffA);
    PG8_WAIT_V(6); PG8_BAR;
    for (;;) {
        const bool has_next = sched_next(g, ui + 1, cidx, G, nxt);
        const char* nA = has_next ? g.A + nxt.aoff : cA; const char* nB = has_next ? g.Bt + nxt.boff : cB;
        const int nt = cur.nt;
        for (int t = 0; t < nt; t += 2) {
            const bool last = (t == nt - 2);
            const char* a1 = cA + (size_t)(t + 1) * kstep;
            const char* a2 = last ? nA : cA + (size_t)(t + 2) * kstep; const char* b2 = last ? nB : cB + (size_t)(t + 2) * kstep;
            const char* a3 = a2 + kstep; const char* b3 = b2 + kstep;
            PG8_LDB(B0, 0, 0); PG8_SCHED; PG8_LDA(At, 0, 0); PG8_STAGE(PG8_SA(1, 1), a1 + hstepA, voffA);
            PG8_WAIT_L(8); PG8_BAR; PG8_WAIT_L(0); PG8_MMA(0, 0, At, B0); PG8_BAR; PG8_SCHED;
            PG8_LDB(B1, 0, 1); PG8_STAGE(PG8_SB(0, 0), b2, voffA);
            PG8_BAR; PG8_WAIT_L(0); PG8_MMA(0, 1, At, B1); PG8_BAR;
            PG8_LDA(At, 0, 1); PG8_STAGE(PG8_SA(0, 0), a2, voffA);
            PG8_BAR; PG8_WAIT_L(0); PG8_MMA(1, 0, At, B0); PG8_BAR; PG8_SCHED;
            PG8_STAGE(PG8_SB(0, 1), b2 + hstepA, voffA);
            PG8_WAIT_V(6); PG8_BAR; PG8_MMA(1, 1, At, B1); PG8_BAR;
            PG8_LDB(B0, 1, 0); PG8_SCHED; PG8_LDA(At, 1, 0); PG8_STAGE(PG8_SA(0, 1), a2 + hstepA, voffA);
            PG8_WAIT_L(8); PG8_BAR; PG8_WAIT_L(0); PG8_MMA(0, 0, At, B0); PG8_BAR; PG8_SCHED;
            PG8_LDB(B1, 1, 1); PG8_STAGE(PG8_SB(1, 0), b3, voffA);
            PG8_BAR; PG8_WAIT_L(0); PG8_MMA(0, 1, At, B1); PG8_BAR;
            PG8_LDA(At, 1, 1); PG8_STAGE(PG8_SA(1, 0), a3, voffA);
            PG8_BAR; PG8_WAIT_L(0); PG8_MMA(1, 0, At, B0); PG8_BAR; PG8_SCHED;
            PG8_STAGE(PG8_SB(1, 1), b3 + hstepA, voffA);
            PG8_WAIT_V(6); PG8_BAR; PG8_MMA(1, 1, At, B1); PG8_BAR;
        }
        epilogue(cx, a, l, acc, cur, lds);
        if (!has_next) break;
#pragma unroll
        for (int x = 0; x < 2; ++x)
#pragma unroll
            for (int b = 0; b < 2; ++b)
#pragma unroll
                for (int m = 0; m < 4; ++m)
#pragma unroll
                    for (int n = 0; n < 2; ++n) acc[x][b][m][n] = (f32x4){0.f, 0.f, 0.f, 0.f};
        cur = nxt; cA = nA; cB = nB; ++ui;
    }
    PG8_WAIT_V(0);
    if (wr == 0) PG8_BAR;
    PG8_BAR;
#undef PG8_SA
#undef PG8_SB
#undef PG8_STAGE
#undef PG8_LDA
#undef PG8_LDB
#undef PG8_MMA
#undef PG8_WAIT_V
#undef PG8_WAIT_L
#undef PG8_BAR
#undef PG8_SCHED
}

__device__ __forceinline__ int rope_src(int dp) { const int n = dp >> 4, ip = dp & 15; return (ip >> 3) * 16 + n * 8 + (ip & 7); }
__device__ __forceinline__ int mixin_src_col(int n) {
    const int t = n >> 8, w = n & 255;
    if (t < 4) return (w >> 7) * 512 + t * 128 + (w & 127);
    if (t < 6) return 1024 + (t - 4) * 256 + w;
    if (t < 8) return 1536 + (t - 6) * 256 + w;
    if (t < 12) return 2048 + (t - 8) * 256 + w;
    if (t < 16) return 3072 + (t - 12) * 256 + w;
    if (t < 18) return 4096 + (t - 16) * 256 + w;
    if (t == 18) return 4608 + w;
    if (t == 19) return (w < 32) ? 4864 + rope_src(w) : -1;
    return 4896 + (t - 20) * 256 + w;
}
constexpr int PREP_TILES = 352 + 176 + 352 + 176 + 512 + 24 + 16 + 16 + 128 + 128;

__device__ __forceinline__ void prep_tile(const Args& a, int l, int T, unsigned char* smem) {
    bf16_t* tile = (bf16_t*)smem;
    const int tid = otid(), nn = tid & 63, kq = tid >> 6;
    int job, t = T;
    if (t < 352) job = 0; else if ((t -= 352) < 176) job = 1; else if ((t -= 176) < 352) job = 2; else if ((t -= 352) < 176) job = 3;
    else if ((t -= 176) < 512) job = 4; else if ((t -= 512) < 24) job = 5; else if ((t -= 24) < 16) job = 6; else if ((t -= 16) < 16) job = 7;
    else if ((t -= 16) < 128) job = 8; else { t -= 128; job = 9; }
    const float* src = nullptr; const float* kscale = nullptr; size_t ld = 0; int ksrc0 = 0, col = 0, n0 = 0, k0 = 0; size_t ldd = 0; bf16_t* dst = nullptr;
    unsigned char* W = a.ws;
    switch (job) {
    case 0: case 2: { const int tk = t & 3, tn = t >> 2; n0 = tn * 64; k0 = tk * 256; const int n = ((n0 + nn) & ~31) + perm32((n0 + nn) & 31);
        src = a.in[job == 0 ? I_F1IN : I_F2IN] + (size_t)l * 1024 * 5632; ld = 5632; ksrc0 = k0;
        col = ((n & 255) >> 7) * 2816 + (n >> 8) * 128 + (n & 127); dst = (bf16_t*)(W + (job == 0 ? W_FFN1_IN : W_FFN2_IN)); ldd = 1024; } break;
    case 1: case 3: { const int tk = t % 11, tn = t / 11; n0 = tn * 64; k0 = tk * 256;
        src = a.in[job == 1 ? I_F1OUT : I_F2OUT] + (size_t)l * 2816 * 1024; ld = 1024; ksrc0 = k0; col = ((n0 + nn) & ~31) + perm32((n0 + nn) & 31);
        dst = (bf16_t*)(W + (job == 1 ? W_FFN1_OUT : W_FFN2_OUT)); ldd = 2816; } break;
    case 4: { const int tk = t & 3, tn = t >> 2; n0 = tn * 64; k0 = tk * 256;
        src = a.in[I_MIXIN] + (size_t)l * 1024 * 7968; ld = 7968; ksrc0 = k0; { const int n = n0 + nn, tt = n >> 8; const bool pm_ = (tt < 6) || (tt >= 12 && tt < 16) || (tt >= 20); col = mixin_src_col(pm_ ? (n & ~31) + perm32(n & 31) : n); } dst = (bf16_t*)(W + W_MIX_IN); ldd = 1024; } break;
    case 5: { const int tk = t & 1, tn = t >> 1; n0 = tn * 64; k0 = tk * 256; const int n = n0 + nn, tt = n >> 8, w = n & 255;
        src = a.in[I_WUQ] + (size_t)l * 512 * 768; ld = 768; ksrc0 = k0; kscale = a.in[I_QNORM] + l * 512;
        col = (tt < 2) ? (4 * tt + (w >> 6)) * 96 + (w & 63) : (w >> 5) * 96 + 64 + rope_src(w & 31);
        dst = (bf16_t*)(W + W_M2); ldd = 768; } break;
    case 6: case 7: { n0 = t * 64; k0 = 0;
        src = a.in[I_WUKV] + (size_t)l * 256 * 1024; ld = 1024; ksrc0 = 0; col = n0 + nn; if (job == 6) kscale = a.in[I_KVNORM] + l * 256;
        dst = (bf16_t*)(W + W_M2) + (size_t)(job == 6 ? 768 : 1792) * 768; ldd = 768; } break;
    case 8: { const int tk = t & 7, tn = t >> 3; n0 = tn * 64; k0 = tk * 256; col = ((n0 + nn) & ~31) + perm32((n0 + nn) & 31); ld = 1024;
        if (k0 < 1024) { src = a.in[I_RWOUT] + (size_t)l * 1024 * 1024; ksrc0 = k0; }
        else if (k0 < 1536) { src = a.in[I_CWOUT] + (size_t)l * 512 * 1024; ksrc0 = k0 - 1024; }
        else { src = a.in[I_MWOUT] + (size_t)l * 512 * 1024; ksrc0 = k0 - 1536; }
        dst = (bf16_t*)(W + W_BR); ldd = 2048; } break;
    default: { const int tk = t & 7, tn = t >> 3; n0 = tn * 64; k0 = tk * 256; col = ((n0 + nn) & ~31) + perm32((n0 + nn) & 31); ld = 1024;
        src = a.in[I_WO] + (size_t)l * 1024 * 1024; ksrc0 = k0 & 1023; dst = (bf16_t*)(W + W_O2); ldd = 2048; } break;
    }
    {
        const float* sp = src + (size_t)ksrc0 * ld + (col >= 0 ? col : 0);
        float v0[16], v1[16];
#pragma unroll
        for (int i = 0; i < 16; ++i) { const int kk = 2 * (kq + 8 * i); v0[i] = sp[(size_t)kk * ld]; v1[i] = sp[(size_t)(kk + 1) * ld]; }
#pragma unroll
        for (int i = 0; i < 16; ++i) {
            const int kk = 2 * (kq + 8 * i);
            float x0 = v0[i], x1 = v1[i];
            if (kscale) { x0 *= kscale[ksrc0 + kk]; x1 *= kscale[ksrc0 + kk + 1]; }
            if (col < 0) { x0 = 0.f; x1 = 0.f; }
            *(unsigned*)(tile + nn * 264 + kk) = cvt_pk_bf16(x0, x1);
        }
    }
    __syncthreads();
#pragma unroll
    for (int j = 0; j < 4; ++j) {
        const int idx = tid + 512 * j, nn2 = idx >> 5, kk8 = (idx & 31) * 8;
        *(u32x4*)(dst + (size_t)(n0 + nn2) * ldd + k0 + kk8) = *(const u32x4*)(tile + nn2 * 264 + kk8);
    }
    __syncthreads();
}

__device__ __forceinline__ void ada_phase(const Args& a, const Ctx& cx, unsigned char* smem) {
    float* sl = (float*)smem;
    float* red = (float*)(smem + 20480);
    const int tid = otid();
    for (int e = tid; e < 5 * 1024; e += 512) { const int ci = e >> 10, k = e & 1023; const float x = (ci == 0) ? a.in[I_CCTX][k] : a.in[I_C][(ci - 1) * 1024 + k]; sl[e] = silu(x); }
    __syncthreads();
    const int cgp = tid & 7, kg = tid >> 3;
    for (int task = (int)gridDim.x - 1 - (int)blockIdx.x; task < 576; task += gridDim.x) {
        const int l = task / 288, col0 = (task % 288) * 32;
        f32x4 acc[5];
#pragma unroll
        for (int ci = 0; ci < 5; ++ci) acc[ci] = (f32x4){0.f, 0.f, 0.f, 0.f};
        const float* wp = a.in[I_ADAW] + ((size_t)l * 1024 + kg * 16) * 9216 + col0 + cgp * 4;
#pragma unroll 4
        for (int kk = 0; kk < 16; ++kk) {
            const f32x4 w = *(const f32x4*)(wp + (size_t)kk * 9216);
#pragma unroll
            for (int ci = 0; ci < 5; ++ci) acc[ci] += w * sl[ci * 1024 + kg * 16 + kk];
        }
#pragma unroll
        for (int ci = 0; ci < 5; ++ci) *(f32x4*)(red + (kg * 5 + ci) * 32 + cgp * 4) = acc[ci];
        __syncthreads();
        if (tid < 160) {
            const int ci = tid >> 5, cc = tid & 31; float s = 0.f;
            for (int k2 = 0; k2 < 64; ++k2) s += red[(k2 * 5 + ci) * 32 + cc];
            cx.MOD()[((size_t)l * 5 + ci) * 9216 + col0 + cc] = s + a.in[I_ADAB][(size_t)l * 9216 + col0 + cc];
        }
        __syncthreads();
    }
}

#ifndef LN_NR
#define LN_NR 4
#endif
__device__ __forceinline__ void ln_phase(const Args& a, const Ctx& cx, int l, int s) {
    const int tid_ = otid(), lane = tid_ & 63, wave = tid_ >> 6;
    float* X = cx.out;
    const int nl = (s < 0) ? 0 : (s == 2 ? l + 1 : l), nm = (s < 0) ? 0 : (s == 2 ? 0 : 3 * (s + 1));
    const bool have_h = (nl < 2);
    const int rstride = gridDim.x * 8;
    for (int row0 = blockIdx.x * 8 + wave; row0 < NTOK; row0 += LN_NR * rstride) {
        f32x4 xn[LN_NR][4];
        int rows[LN_NR], cis[LN_NR];
#pragma unroll
        for (int rr = 0; rr < LN_NR; ++rr) { int r = row0 + rr * rstride; if (r >= NTOK) r = row0; rows[rr] = r; cis[rr] = r < 4096 ? 0 : 1 + ((r - 4096) >> 10); }
        if (s < 0) {
#pragma unroll
            for (int rr = 0; rr < LN_NR; ++rr) {
                const int row = rows[rr];
                const float* xp = (row < 4096) ? a.in[I_XP] + (size_t)row * 1024 : a.in[I_XS] + (size_t)(row - 4096) * 1024;
#pragma unroll
                for (int q = 0; q < 4; ++q) xn[rr][q] = *(const f32x4*)(xp + q * 256 + lane * 4);
            }
        } else {
            const float gs = (s == 1) ? 1.0f : 0.5f;
            float sum[LN_NR]; for (int rr = 0; rr < LN_NR; ++rr) sum[rr] = 0.f;
#pragma unroll
            for (int rr = 0; rr < LN_NR; ++rr) {
                const int row = rows[rr];
                const float* modl = cx.MOD() + ((size_t)l * 5 + cis[rr]) * 9216 + (3 * s + 2) * 1024;
                const float* xres = (l == 0 && s == 0) ? ((row < 4096) ? a.in[I_XP] + (size_t)row * 1024 : a.in[I_XS] + (size_t)(row - 4096) * 1024) : X + (size_t)row * 1024;
                const bf16_t* f0 = (const bf16_t*)cx.F() + (size_t)row * 1024; const bf16_t* f1 = (const bf16_t*)cx.F() + ((size_t)NTOK + row) * 1024;
#pragma unroll
                for (int q = 0; q < 4; ++q) {
                    const int c = q * 256 + lane * 4;
                    const f32x4 xo = *(const f32x4*)(xres + c), g = *(const f32x4*)(modl + c), p0 = unpack4(*(const u32x2*)(f0 + c)), p1 = unpack4(*(const u32x2*)(f1 + c));
                    xn[rr][q] = xo * ALPHA + (g * gs) * (p0 + p1);
                    sum[rr] += (xn[rr][q][0] + xn[rr][q][1]) + (xn[rr][q][2] + xn[rr][q][3]);
                }
            }
            const float* lg = a.in[I_LNG] + (size_t)(l * 3 + s) * 1024; const float* lb = a.in[I_LNB] + (size_t)(l * 3 + s) * 1024;
#pragma unroll
            for (int rr = 0; rr < LN_NR; ++rr) {
                const float mean = wave_sum(sum[rr]) * (1.0f / 1024.0f);
                float sq = 0.f;
#pragma unroll
                for (int q = 0; q < 4; ++q) { xn[rr][q] = xn[rr][q] - mean; sq += (xn[rr][q][0] * xn[rr][q][0] + xn[rr][q][1] * xn[rr][q][1]) + (xn[rr][q][2] * xn[rr][q][2] + xn[rr][q][3] * xn[rr][q][3]); }
                const float rstd = rsqrtf(wave_sum(sq) * (1.0f / 1024.0f) + 1e-5f);
#pragma unroll
                for (int q = 0; q < 4; ++q) {
                    const int c = q * 256 + lane * 4;
                    xn[rr][q] = xn[rr][q] * rstd * *(const f32x4*)(lg + c) + *(const f32x4*)(lb + c);
                    *(f32x4*)(X + (size_t)rows[rr] * 1024 + c) = xn[rr][q];
                }
            }
        }
        if (have_h) {
#pragma unroll
            for (int rr = 0; rr < LN_NR; ++rr) {
                const float* mn = cx.MOD() + ((size_t)nl * 5 + cis[rr]) * 9216 + nm * 1024;
#pragma unroll
                for (int q = 0; q < 4; ++q) {
                    const int c = q * 256 + lane * 4;
                    const f32x4 sh = *(const f32x4*)(mn + c), sc = *(const f32x4*)(mn + 1024 + c);
                    *(u32x2*)(cx.H() + (size_t)rows[rr] * 1024 + c) = pack4(xn[rr][q] * (sc + 1.0f) + sh);
                }
            }
        }
    }
}

__device__ __forceinline__ void cache_prep(const Args& a, const Ctx& cx, int l) {
    const size_t gtid = (size_t)blockIdx.x * 512 + otid(), gsz = (size_t)gridDim.x * 512;
    for (size_t e = gtid; e < 1024 * 64; e += gsz) {
        const int rr = (int)(e >> 6), c4 = (int)(e & 63) * 4, b = rr >> 8, t = rr & 255;
        const f32x4 v = *(const f32x4*)(a.in[I_CKV] + (((size_t)b * 2 + l) * 256 + t) * 256 + c4);
        *(u32x2*)(cx.MQKV() + (size_t)(8192 + rr) * 768 + 512 + c4) = pack4(v);
    }
    for (size_t e = gtid; e < 1024 * 32; e += gsz) {
        const int rr = (int)(e >> 5), dp = (int)(e & 31), b = rr >> 8, t = rr & 255;
        const float v = a.in[I_CKR][(((size_t)b * 2 + l) * 256 + t) * 32 + rope_src(dp)];
        cx.KROPE()[(size_t)(4096 + 1280 * b + t) * 32 + dp] = f2bf(v);
    }
    for (size_t e = gtid; e < (size_t)16 * 2 * 32768; e += gsz) {
        const int dv = (int)(e & 255), dk = (int)((e >> 8) & 127), dir = (int)((e >> 15) & 1), bh = (int)(e >> 16), b = bh >> 2, h = bh & 3;
        const float v = a.in[dir ? I_SB : I_SF][((((size_t)b * 2 + l) * 4 + h) * 128 + dk) * 256 + dv];
        cx.S0T()[((size_t)bh * 2 + dir) * 32768 + (size_t)dv * 128 + dk] = v;
    }
}

__device__ __forceinline__ void conv_rows(const Args& a, const Ctx& cx, int l, unsigned char* smem) {
    const int tid_ = otid(), lane = tid_ & 63, wave = tid_ >> 6;
    float* wl = (float*)smem;
    {
        const float* wsrc = a.in[I_CWDW] + (size_t)l * 31 * 512;
        for (int e = tid_; e < 31 * 128; e += 512) *(f32x4*)(wl + e * 4) = *(const f32x4*)(wsrc + e * 4);
    }
    __syncthreads();
    for (int rgp = blockIdx.x * 8 + wave; rgp < NTOK / 4; rgp += gridDim.x * 8) {
        const int row0 = rgp * 4;
        int rowbase, T, t0;
        if (row0 < 4096) { rowbase = row0 & ~255; t0 = row0 & 255; T = 256; } else { rowbase = 4096 + ((row0 - 4096) & ~1023); t0 = (row0 - 4096) & 1023; T = 1024; }
        f32x4 c0[4], c1[4];
#pragma unroll
        for (int i = 0; i < 4; ++i) { c0[i] = *(const f32x4*)(a.in[I_CBDW] + l * 512 + lane * 8); c1[i] = *(const f32x4*)(a.in[I_CBDW] + l * 512 + lane * 8 + 4); }
#pragma unroll
        for (int jc = 0; jc < 5; ++jc) {
            u32x4 raw[8]; float vld[8];
#pragma unroll
            for (int jj = 0; jj < 8; ++jj) {
                const int j = jc * 8 + jj;
                if (j < 34) {
                    const int tt = t0 - 15 + j;
                    const int ttc = tt < 0 ? 0 : (tt >= T ? T - 1 : tt);
                    vld[jj] = (tt >= 0 && tt < T) ? 1.0f : 0.0f;
                    raw[jj] = *(const u32x4*)(cx.HGLU() + (size_t)(rowbase + ttc) * 512 + lane * 8);
                }
            }
#pragma unroll
            for (int jj = 0; jj < 8; ++jj) {
                const int j = jc * 8 + jj;
                if (j < 34) {
                    const f32x4 x0 = (f32x4){bflo(raw[jj].x), bfhi(raw[jj].x), bflo(raw[jj].y), bfhi(raw[jj].y)} * vld[jj];
                    const f32x4 x1 = (f32x4){bflo(raw[jj].z), bfhi(raw[jj].z), bflo(raw[jj].w), bfhi(raw[jj].w)} * vld[jj];
#pragma unroll
                    for (int i = 0; i < 4; ++i) {
                        const int tap = j - i;
                        if (tap >= 0 && tap < 31) {
                            c0[i] += x0 * *(const f32x4*)(wl + tap * 512 + lane * 8);
                            c1[i] += x1 * *(const f32x4*)(wl + tap * 512 + lane * 8 + 4);
                        }
                    }
                }
            }
        }
        const float* lg = a.in[I_CLNG] + l * 512 + lane * 8; const float* lb = a.in[I_CLNB] + l * 512 + lane * 8;
        const f32x4 g0 = *(const f32x4*)(lg), g1 = *(const f32x4*)(lg + 4), b0 = *(const f32x4*)(lb), b1 = *(const f32x4*)(lb + 4);
#pragma unroll
        for (int i = 0; i < 4; ++i) {
            f32x4 y0 = c0[i], y1 = c1[i];
            const float mean = wave_sum((y0[0] + y0[1]) + (y0[2] + y0[3]) + (y1[0] + y1[1]) + (y1[2] + y1[3])) * (1.0f / 512.0f);
            y0 = y0 - mean; y1 = y1 - mean;
            const float var = wave_sum((y0[0] * y0[0] + y0[1] * y0[1]) + (y0[2] * y0[2] + y0[3] * y0[3]) + (y1[0] * y1[0] + y1[1] * y1[1]) + (y1[2] * y1[2] + y1[3] * y1[3])) * (1.0f / 512.0f);
            const float rstd = rsqrtf(var + 1e-5f);
            y0 = y0 * rstd * g0 + b0; y1 = y1 * rstd * g1 + b1;
#pragma unroll
            for (int j = 0; j < 4; ++j) { y0[j] = silu(y0[j]); y1[j] = silu(y1[j]); }
            u32x4 w; w.x = cvt_pk_bf16(y0[0], y0[1]); w.y = cvt_pk_bf16(y0[2], y0[3]); w.z = cvt_pk_bf16(y1[0], y1[1]); w.w = cvt_pk_bf16(y1[2], y1[3]);
            *(u32x4*)(cx.BR() + (size_t)(row0 + i) * 2048 + 1024 + lane * 8) = w;
        }
    }
    __syncthreads();
}

__device__ __forceinline__ void ckv_out_rows(const Args& a, const Ctx& cx, int l) {
    const int tid_ = otid(), lane = tid_ & 63, wave = tid_ >> 6;
    const f32x4 g = *(const f32x4*)(a.in[I_KVNORM] + l * 256 + lane * 4);
    for (int row = blockIdx.x * 8 + wave; row < 4096; row += gridDim.x * 8) {
        const f32x4 s0 = *(const f32x4*)(cx.SSQKV() + (size_t)row * 4);
        const float rs = rsqrtf(((s0[0] + s0[1]) + (s0[2] + s0[3])) * (1.0f / 256.0f) + 1e-6f);
        float* o = cx.out + OUT_CKV + ((size_t)((row >> 8) * 2 + l) * 256 + (row & 255)) * 256 + lane * 4;
        *(f32x4*)o = *(const f32x4*)o * rs * g;
    }
}

struct RetUnit { int rowbase, T, h, c, bh; bool ctx; };
__device__ __forceinline__ RetUnit ret_decode(int u) {
    RetUnit r;
    if (u < 128) { r.ctx = true; r.bh = u >> 1; r.h = (u & 7) >> 1; r.c = u & 1; r.rowbase = (u >> 3) * 256; r.T = 256; }
    else { const int v = u - 128; r.ctx = false; r.bh = v >> 3; r.h = (v & 31) >> 3; r.c = v & 7; r.rowbase = 4096 + (v >> 5) * 1024; r.T = 1024; }
    return r;
}
__device__ __forceinline__ float log2_sigmoid(float x) { return -log2f(1.0f + expf(-x)); }

__device__ __forceinline__ void r1_unit(const Args& a, const Ctx& cx, int l, int u, unsigned char* smem) {
    const RetUnit ru = ret_decode(u);
    const int tid_ = otid(), lane = tid_ & 63, wave = tid_ >> 6, lr = lane & 15, lg = lane >> 4;
    const float lgf = log2_sigmoid(a.in[I_RDF][l * 4 + ru.h]), lgb = log2_sigmoid(a.in[I_RDB][l * 4 + ru.h]);
    const size_t T = (size_t)ru.T;
    const bf16_t* vT = cx.VRT() + (size_t)ru.rowbase * 1024 + (size_t)(ru.h * 256) * T + ru.c * 128;
    const bf16_t* kT = cx.KRT() + (size_t)ru.rowbase * 512 + (size_t)(ru.h * 128) * T + ru.c * 128;
    bf16_t* kTs = (bf16_t*)smem;
    bf16_t* vTs = (bf16_t*)(smem + 34816);
    {
        u32x4 kr[4], vr[8];
#pragma unroll
        for (int j = 0; j < 4; ++j) { const int idx = tid_ + 512 * j; kr[j] = *(const u32x4*)(kT + (size_t)(idx >> 4) * T + (idx & 15) * 8); }
#pragma unroll
        for (int j = 0; j < 8; ++j) { const int idx = tid_ + 512 * j; vr[j] = *(const u32x4*)(vT + (size_t)(idx >> 4) * T + (idx & 15) * 8); }
#pragma unroll
        for (int j = 0; j < 4; ++j) { const int idx = tid_ + 512 * j; *(u32x4*)(kTs + (idx >> 4) * 136 + (idx & 15) * 8) = kr[j]; }
#pragma unroll
        for (int j = 0; j < 8; ++j) { const int idx = tid_ + 512 * j; *(u32x4*)(vTs + (idx >> 4) * 136 + (idx & 15) * 8) = vr[j]; }
    }
    __syncthreads();
#pragma unroll 1
    for (int dir = 0; dir < 2; ++dir) {
        const float lgd = dir ? lgb : lgf;
        f32x4 acc[2][8];
#pragma unroll
        for (int mt = 0; mt < 2; ++mt)
#pragma unroll
            for (int nt = 0; nt < 8; ++nt) acc[mt][nt] = (f32x4){0.f, 0.f, 0.f, 0.f};
#pragma unroll
        for (int ks = 0; ks < 4; ++ks) {
            const int j0 = ks * 32 + lg * 8;
            float z[8];
#pragma unroll
            for (int e = 0; e < 8; ++e) z[e] = __builtin_amdgcn_exp2f((float)(dir ? (j0 + e) : 127 - (j0 + e)) * lgd);
            bf16x8 af[2];
#pragma unroll
            for (int mt = 0; mt < 2; ++mt) {
                const u32x4 raw = *(const u32x4*)(vTs + (wave * 32 + mt * 16 + lr) * 136 + j0);
                FragU f;
                f.u.x = cvt_pk_bf16(bflo(raw.x) * z[0], bfhi(raw.x) * z[1]); f.u.y = cvt_pk_bf16(bflo(raw.y) * z[2], bfhi(raw.y) * z[3]);
                f.u.z = cvt_pk_bf16(bflo(raw.z) * z[4], bfhi(raw.z) * z[5]); f.u.w = cvt_pk_bf16(bflo(raw.w) * z[6], bfhi(raw.w) * z[7]);
                af[mt] = f.v;
            }
#pragma unroll
            for (int nt = 0; nt < 8; ++nt) {
                const bf16x8 kf = *(const bf16x8*)(kTs + (nt * 16 + lr) * 136 + j0);
#pragma unroll
                for (int mt = 0; mt < 2; ++mt) acc[mt][nt] = MFMA16(kf, af[mt], acc[mt][nt]);
            }
        }
        float* o = cx.KVT() + ((size_t)u * 2 + dir) * 32768;
        if (ru.ctx) {
#pragma unroll
            for (int mt = 0; mt < 2; ++mt)
#pragma unroll
                for (int nt = 0; nt < 8; ++nt) *(f32x4*)(o + (wave * 32 + mt * 16 + lr) * 128 + nt * 16 + lg * 4) = acc[mt][nt];
        } else {
            bf16_t* ob = (bf16_t*)o;
#pragma unroll
            for (int mt = 0; mt < 2; ++mt)
#pragma unroll
                for (int nt = 0; nt < 8; ++nt) *(u32x2*)(ob + (wave * 32 + mt * 16 + lr) * 128 + nt * 16 + lg * 4) = pack4(acc[mt][nt]);
        }
    }
    __syncthreads();
}

__device__ __forceinline__ void r2_unit(const Args& a, const Ctx& cx, int l, int u, unsigned char* smem) {
    const RetUnit ru = ret_decode(u);
    const int tid = otid(), lane = tid & 63, wave = tid >> 6, lr = lane & 15, lg = lane >> 4;
    const float lgf = log2_sigmoid(a.in[I_RDF][l * 4 + ru.h]), lgb = log2_sigmoid(a.in[I_RDB][l * 4 + ru.h]);
    const size_t T = (size_t)ru.T;
    bf16_t* Sbuf = (bf16_t*)smem;
    bf16_t* Pw = (bf16_t*)(smem + 69632) + wave * (16 * 136);
    const int crow = ru.rowbase + ru.c * 128;
    const int il = wave * 16 + lr;
    bf16x8 qf[4];
#pragma unroll
    for (int ks = 0; ks < 4; ++ks) qf[ks] = ldfrag(cx.QR() + (size_t)(crow + il) * 512 + ru.h * 128 + ks * 32 + lg * 8);
    const bf16_t* vT = cx.VRT() + (size_t)ru.rowbase * 1024 + (size_t)(ru.h * 256) * T + ru.c * 128;
    {
        u32x4 kreg[4];
#pragma unroll
        for (int j = 0; j < 4; ++j) { const int idx = tid + 512 * j; kreg[j] = *(const u32x4*)(cx.KR() + (size_t)(crow + (idx >> 4)) * 512 + ru.h * 128 + (idx & 15) * 8); }
#pragma unroll
        for (int j = 0; j < 4; ++j) { const int idx = tid + 512 * j; *(u32x4*)(Sbuf + (idx >> 4) * 136 + (idx & 15) * 8) = kreg[j]; }
    }
    __syncthreads();
    u32x4 vreg[8];
#pragma unroll
    for (int j = 0; j < 8; ++j) { const int idx = tid + 512 * j; vreg[j] = *(const u32x4*)(vT + (size_t)(idx >> 4) * T + (idx & 15) * 8); }
#pragma unroll
    for (int nt = 0; nt < 8; ++nt) {
        f32x4 sa = (f32x4){0.f, 0.f, 0.f, 0.f};
#pragma unroll
        for (int ks = 0; ks < 4; ++ks) { const bf16x8 kf = *(const bf16x8*)(Sbuf + (nt * 16 + lr) * 136 + ks * 32 + lg * 8); sa = MFMA16(kf, qf[ks], sa); }
        f32x4 p;
#pragma unroll
        for (int rg = 0; rg < 4; ++rg) { const int j = nt * 16 + lg * 4 + rg, d = il - j; p[rg] = sa[rg] * __builtin_amdgcn_exp2f(d >= 0 ? (float)d * lgf : (float)(-d) * lgb); }
        *(u32x2*)(Pw + lr * 136 + nt * 16 + lg * 4) = pack4(p);
    }
    __syncthreads();
#pragma unroll
    for (int j = 0; j < 8; ++j) { const int idx = tid + 512 * j; *(u32x4*)(Sbuf + (idx >> 4) * 136 + (idx & 15) * 8) = vreg[j]; }
    bf16x8 pf[4];
#pragma unroll
    for (int ks = 0; ks < 4; ++ks) pf[ks] = *(const bf16x8*)(Pw + lr * 136 + ks * 32 + lg * 8);
    __syncthreads();
    f32x4 oacc[16];
#pragma unroll
    for (int nt2 = 0; nt2 < 16; ++nt2) {
        f32x4 o = (f32x4){0.f, 0.f, 0.f, 0.f};
#pragma unroll
        for (int ks = 0; ks < 4; ++ks) { const bf16x8 vf = *(const bf16x8*)(Sbuf + (nt2 * 16 + lr) * 136 + ks * 32 + lg * 8); o = MFMA16(vf, pf[ks], o); }
        oacc[nt2] = o;
    }
    const int nc = ru.ctx ? 2 : 8;
    for (int dir = 0; dir < 2; ++dir) {
        const bool have = ru.ctx ? (dir == 0 ? ru.c == 1 : ru.c == 0) : true;
        if (!have) continue;
        const float lgd = dir ? lgb : lgf;
        __syncthreads();
        {
            int nterm;
            if (ru.ctx) nterm = 1; else nterm = dir == 0 ? ru.c + 1 : nc - ru.c;
#pragma unroll 1
            for (int hf = 0; hf < 2; ++hf) {
                f32x4 sacc[8];
#pragma unroll
                for (int it = 0; it < 8; ++it) sacc[it] = (f32x4){0.f, 0.f, 0.f, 0.f};
                if (ru.ctx) {
                    const float* p = cx.KVT() + ((size_t)(dir == 0 ? u - 1 : u + 1) * 2 + dir) * 32768;
#pragma unroll
                    for (int it = 0; it < 8; ++it) sacc[it] = *(const f32x4*)(p + (size_t)((hf * 8 + it) * 512 + tid) * 4);
                } else {
                    {
                        const float* p = cx.S0T() + ((size_t)ru.bh * 2 + dir) * 32768;
                        const float w = exp2f((float)((dir == 0 ? ru.c : nc - 1 - ru.c) * 128) * lgd);
#pragma unroll
                        for (int it = 0; it < 8; ++it) sacc[it] = *(const f32x4*)(p + (size_t)((hf * 8 + it) * 512 + tid) * 4) * w;
                    }
                    for (int m = 1; m < nterm; m += 4) {
                        const bf16_t* p[4]; float w[4];
#pragma unroll
                        for (int q = 0; q < 4; ++q) {
                            const int mm = (m + q < nterm) ? m + q : m;
                            if (dir == 0) { p[q] = (const bf16_t*)(cx.KVT() + ((size_t)(u - ru.c + (mm - 1)) * 2 + 0) * 32768); w[q] = exp2f((float)((ru.c - mm) * 128) * lgd); }
                            else { p[q] = (const bf16_t*)(cx.KVT() + ((size_t)(u + mm) * 2 + 1) * 32768); w[q] = exp2f((float)((mm - 1) * 128) * lgd); }
                            if (m + q >= nterm) w[q] = 0.f;
                        }
                        u32x2 ldq[4][8];
#pragma unroll
                        for (int q = 0; q < 4; ++q)
#pragma unroll
                            for (int it = 0; it < 8; ++it) ldq[q][it] = *(const u32x2*)(p[q] + (size_t)((hf * 8 + it) * 512 + tid) * 4);
#pragma unroll
                        for (int q = 0; q < 4; ++q)
#pragma unroll
                            for (int it = 0; it < 8; ++it) sacc[it] += unpack4(ldq[q][it]) * w[q];
                    }
                }
#pragma unroll
                for (int it = 0; it < 8; ++it) { const int e4 = (hf * 8 + it) * 512 + tid; *(u32x2*)(Sbuf + (e4 >> 5) * 136 + (e4 & 31) * 4) = pack4(sacc[it]); }
            }
        }
        __syncthreads();
        const float xi = dir == 0 ? exp2f((float)(il + 1) * lgf) : exp2f((float)(128 - il) * lgb);
#pragma unroll
        for (int nt2 = 0; nt2 < 16; ++nt2) {
            f32x4 cacc = (f32x4){0.f, 0.f, 0.f, 0.f};
#pragma unroll
            for (int ks = 0; ks < 4; ++ks) { const bf16x8 sf = *(const bf16x8*)(Sbuf + (nt2 * 16 + lr) * 136 + ks * 32 + lg * 8); cacc = MFMA16(sf, qf[ks], cacc); }
            oacc[nt2] += cacc * xi;
        }
    }
    float sum = 0.f;
#pragma unroll
    for (int nt2 = 0; nt2 < 16; ++nt2) sum += (oacc[nt2][0] + oacc[nt2][1]) + (oacc[nt2][2] + oacc[nt2][3]);
    sum += __shfl_xor(sum, 16); sum += __shfl_xor(sum, 32);
    const float mean = sum * (1.0f / 256.0f);
    float sq = 0.f;
#pragma unroll
    for (int nt2 = 0; nt2 < 16; ++nt2) { oacc[nt2] = oacc[nt2] - mean; sq += (oacc[nt2][0] * oacc[nt2][0] + oacc[nt2][1] * oacc[nt2][1]) + (oacc[nt2][2] * oacc[nt2][2] + oacc[nt2][3] * oacc[nt2][3]); }
    sq += __shfl_xor(sq, 16); sq += __shfl_xor(sq, 32);
    const float rstd = rsqrtf(sq * (1.0f / 256.0f) + 1e-5f);
    const size_t row = (size_t)(crow + il);
    u32x2 gts[16];
#pragma unroll
    for (int nt2 = 0; nt2 < 16; ++nt2) gts[nt2] = *(const u32x2*)(cx.GR() + row * 1024 + ru.h * 256 + nt2 * 16 + lg * 4);
#pragma unroll
    for (int nt2 = 0; nt2 < 16; ++nt2) {
        const int col = ru.h * 256 + nt2 * 16 + lg * 4;
        *(u32x2*)(cx.BR() + row * 2048 + col) = pack4(oacc[nt2] * rstd * unpack4(gts[nt2]));
    }
    if (ru.ctx) {
        const int c = ru.c, s = u >> 3;
        float* o = cx.out + (c == 0 ? OUT_RF : OUT_RB) + ((size_t)(s * 2 + l) * 4 + ru.h) * 32768;
        const float* A = cx.KVT() + ((size_t)u * 2 + c) * 32768;
        const float* B = cx.KVT() + ((size_t)(c == 0 ? u + 1 : u - 1) * 2 + c) * 32768;
        const float w = exp2f(128.0f * (c == 0 ? lgf : lgb));
        float* Tt = (float*)smem;
#pragma unroll 1
        for (int q4 = 0; q4 < 4; ++q4) {
            __syncthreads();
            f32x4 va[4], vb[4];
#pragma unroll
            for (int j = 0; j < 4; ++j) { const int idx = tid + 512 * j, dvl = idx >> 5, dk4 = (idx & 31) * 4; va[j] = *(const f32x4*)(A + (q4 * 64 + dvl) * 128 + dk4); vb[j] = *(const f32x4*)(B + (q4 * 64 + dvl) * 128 + dk4); }
#pragma unroll
            for (int j = 0; j < 4; ++j) { const int idx = tid + 512 * j, dvl = idx >> 5, dk4 = (idx & 31) * 4; const f32x4 r = va[j] * w + vb[j];
                Tt[dvl * 129 + dk4] = r[0]; Tt[dvl * 129 + dk4 + 1] = r[1]; Tt[dvl * 129 + dk4 + 2] = r[2]; Tt[dvl * 129 + dk4 + 3] = r[3]; }
            __syncthreads();
#pragma unroll
            for (int j = 0; j < 4; ++j) { const int idx = tid + 512 * j, dk = idx >> 4, dq = (idx & 15) * 4;
                const f32x4 r = (f32x4){Tt[dq * 129 + dk], Tt[(dq + 1) * 129 + dk], Tt[(dq + 2) * 129 + dk], Tt[(dq + 3) * 129 + dk]};
                *(f32x4*)(o + dk * 256 + q4 * 64 + dq) = r; }
        }
    }
    __syncthreads();
}

__device__ __forceinline__ void attn_unit(const Ctx& cx, int uidx, unsigned char* smem) {
    const int tid = otid(), lane = tid & 63, wave = tid >> 6, lr = lane & 15, lg = lane >> 4;
    int qrow0, head, kbase, Tk;
    if (uidx < 256) { const int b = uidx >> 6; head = (uidx & 63) >> 3; qrow0 = 4096 + b * 1024 + (uidx & 7) * 128; kbase = 4096 + 1280 * b; Tk = 1280; }
    else { const int v = uidx - 256, b = v >> 4; head = (v & 15) >> 1; qrow0 = b * 256 + (v & 1) * 128; kbase = b * 256; Tk = 256; }
    constexpr int BUFB = 23552, KR_OFF = 9216, VT_OFF = 14336;
    bf16_t* Pw = (bf16_t*)(smem + 2 * BUFB) + wave * (16 * 72);
    const size_t row = (size_t)(qrow0 + wave * 16 + lr);
    bf16x8 qf[3];
#pragma unroll
    for (int ks = 0; ks < 3; ++ks) qf[ks] = ldfrag(cx.Q() + row * 768 + head * 96 + ks * 32 + lg * 8);
    const int r8 = tid >> 3, s8 = tid & 7, r4 = (tid >> 2) & 63, s4 = tid & 3;
    const bf16_t* gk = cx.KN() + (size_t)(kbase + r8) * 512 + head * 64 + s8 * 8;
    const bf16_t* gv = cx.VT() + (size_t)kbase * 512 + (size_t)(head * 64 + r8) * Tk + s8 * 8;
    const bf16_t* gr = cx.KROPE() + (size_t)(kbase + r4) * 32 + s4 * 8;
    const int lk = r8 * 72 + s8 * 8, lrp = r4 * 40 + s4 * 8;
    const int nkb = Tk / 64;
    u32x4 pk = *(const u32x4*)gk, pv = *(const u32x4*)gv, pr = *(const u32x4*)gr;
    {
        bf16_t* b0 = (bf16_t*)smem;
        *(u32x4*)(b0 + lk) = pk; *(u32x4*)(b0 + VT_OFF / 2 + lk) = pv; if (tid < 256) *(u32x4*)(b0 + KR_OFF / 2 + lrp) = pr;
    }
    __syncthreads();
    float m_run = -1e30f, l_part = 0.f;
    f32x4 oacc[4];
#pragma unroll
    for (int i = 0; i < 4; ++i) oacc[i] = (f32x4){0.f, 0.f, 0.f, 0.f};
    for (int kb = 0; kb < nkb; ++kb) {
        const bool more = kb + 1 < nkb;
        if (more) { const size_t k1 = (size_t)(kb + 1) * 64; pk = *(const u32x4*)(gk + k1 * 512); pv = *(const u32x4*)(gv + k1); pr = *(const u32x4*)(gr + k1 * 32); }
        const bf16_t* cb = (const bf16_t*)(smem + (kb & 1) * BUFB);
        f32x4 s[4];
#pragma unroll
        for (int nt = 0; nt < 4; ++nt) {
            const bf16x8 k0 = *(const bf16x8*)(cb + (nt * 16 + lr) * 72 + lg * 8), k1 = *(const bf16x8*)(cb + (nt * 16 + lr) * 72 + 32 + lg * 8),
                         k2 = *(const bf16x8*)(cb + KR_OFF / 2 + (nt * 16 + lr) * 40 + lg * 8);
            f32x4 z = (f32x4){0.f, 0.f, 0.f, 0.f};
            z = MFMA16(k0, qf[0], z); z = MFMA16(k1, qf[1], z); z = MFMA16(k2, qf[2], z);
            s[nt] = z;
        }
        float mx = -1e30f;
#pragma unroll
        for (int nt = 0; nt < 4; ++nt) mx = fmaxf(mx, fmaxf(fmaxf(s[nt][0], s[nt][1]), fmaxf(s[nt][2], s[nt][3])));
        mx = fmaxf(mx, __shfl_xor(mx, 16)); mx = fmaxf(mx, __shfl_xor(mx, 32));
        const float m_new = fmaxf(m_run, mx), alpha = __builtin_amdgcn_exp2f(m_run - m_new);
        m_run = m_new;
        float ps = 0.f;
#pragma unroll
        for (int nt = 0; nt < 4; ++nt) {
#pragma unroll
            for (int rg = 0; rg < 4; ++rg) { s[nt][rg] = __builtin_amdgcn_exp2f(s[nt][rg] - m_new); ps += s[nt][rg]; }
            *(u32x2*)(Pw + lr * 72 + nt * 16 + lg * 4) = pack4(s[nt]);
        }
        l_part = l_part * alpha + ps;
#pragma unroll
        for (int i = 0; i < 4; ++i) oacc[i] = oacc[i] * alpha;
        bf16x8 pf[2];
#pragma unroll
        for (int ks = 0; ks < 2; ++ks) pf[ks] = *(const bf16x8*)(Pw + lr * 72 + ks * 32 + lg * 8);
#pragma unroll
        for (int nt2 = 0; nt2 < 4; ++nt2)
#pragma unroll
            for (int ks = 0; ks < 2; ++ks) { const bf16x8 vf = *(const bf16x8*)(cb + VT_OFF / 2 + (nt2 * 16 + lr) * 72 + ks * 32 + lg * 8); oacc[nt2] = MFMA16(vf, pf[ks], oacc[nt2]); }
        if (more) {
            bf16_t* nb = (bf16_t*)(smem + ((kb + 1) & 1) * BUFB);
            *(u32x4*)(nb + lk) = pk; *(u32x4*)(nb + VT_OFF / 2 + lk) = pv; if (tid < 256) *(u32x4*)(nb + KR_OFF / 2 + lrp) = pr;
        }
        __syncthreads();
    }
    float lt = l_part + __shfl_xor(l_part, 16); lt += __shfl_xor(lt, 32);
    const float inv = 1.0f / lt;
#pragma unroll
    for (int nt2 = 0; nt2 < 4; ++nt2) *(u32x2*)(cx.BR() + row * 2048 + 1536 + head * 64 + nt2 * 16 + lg * 4) = pack4(oacc[nt2] * inv);
}

__device__ __forceinline__ void grid_barrier(unsigned* cnt, unsigned target) {
    asm volatile("s_waitcnt vmcnt(0) lgkmcnt(0)" ::: "memory");
    __syncthreads();
    if (threadIdx.x == 0) {
        __builtin_amdgcn_fence(__ATOMIC_RELEASE, "agent");
        asm volatile("s_waitcnt vmcnt(0)" ::: "memory");
        __hip_atomic_fetch_add(cnt, 1u, __ATOMIC_RELAXED, __HIP_MEMORY_SCOPE_AGENT);
        while (__hip_atomic_load(cnt, __ATOMIC_RELAXED, __HIP_MEMORY_SCOPE_AGENT) < target) __builtin_amdgcn_s_sleep(1);
        __builtin_amdgcn_fence(__ATOMIC_ACQUIRE, "agent");
        asm volatile("s_waitcnt vmcnt(0)" ::: "memory");
    }
    __syncthreads();
}

#define XB_XCNT(j)  (256  + 64 * (j))
#define XB_XSUB(j)  (1280 + 64 * (j))
#define XB_XGEN(j)  (2304 + 64 * (j))
#define XB_TOP      3328
#define XB_TOPGEN   3392
__device__ __forceinline__ unsigned xb_ld(unsigned* p)              { return __hip_atomic_load(p, __ATOMIC_RELAXED, __HIP_MEMORY_SCOPE_AGENT); }
__device__ __forceinline__ unsigned xb_add(unsigned* p, unsigned v) { return __hip_atomic_fetch_add(p, v, __ATOMIC_RELAXED, __HIP_MEMORY_SCOPE_AGENT); }
__device__ __forceinline__ unsigned xb_xcc_id() { return (unsigned)__builtin_amdgcn_s_getreg((3 << 11) | 20) & 0xFu; }
__device__ __forceinline__ void xcd_barrier(unsigned* bar, volatile unsigned* st) {
    asm volatile("s_waitcnt vmcnt(0) lgkmcnt(0)" ::: "memory");
    __syncthreads();
    if (threadIdx.x == 0) {
        const unsigned x = xb_xcc_id();
        unsigned nloc = st[0], nx = st[1];
        if (nloc == 0u) {
            unsigned cntx = 0u, mine = 0u;
#pragma unroll
            for (unsigned j = 0; j < 16; ++j) { const unsigned c = xb_ld(&bar[XB_XCNT(j)]); cntx += (c > 0u) ? 1u : 0u; mine = (j == x) ? c : mine; }
            nloc = mine > 0u ? mine : 1u; nx = cntx > 0u ? cntx : 1u; st[0] = nloc; st[1] = nx;
        }
        const unsigned old = xb_add(&bar[XB_XSUB(x)], 1u);
        const unsigned gen = old / nloc;
        if (old + 1u == (gen + 1u) * nloc) {
            __builtin_amdgcn_fence(__ATOMIC_RELEASE, "agent");
            asm volatile("s_waitcnt vmcnt(0)" ::: "memory");
            const unsigned og = xb_add(&bar[XB_TOP], 1u);
            const unsigned tg = og / nx;
            if (og + 1u == (tg + 1u) * nx) xb_add(&bar[XB_TOPGEN], 1u);
            else while (xb_ld(&bar[XB_TOPGEN]) == tg) __builtin_amdgcn_s_sleep(1);
            __builtin_amdgcn_fence(__ATOMIC_ACQUIRE, "agent");
            xb_add(&bar[XB_XGEN(x)], 1u);
            asm volatile("s_waitcnt vmcnt(0)" ::: "memory");
        } else {
            while (xb_ld(&bar[XB_XGEN(x)]) == gen) __builtin_amdgcn_s_sleep(1);
            __builtin_amdgcn_fence(__ATOMIC_ACQUIRE, "agent");
            asm volatile("s_waitcnt vmcnt(0)" ::: "memory");
        }
    }
    __syncthreads();
}

__global__ void __launch_bounds__(512) mk_fwd(Args a) {
    extern __shared__ __attribute__((aligned(16))) unsigned char smem[];
    Ctx cx;
    cx.ws = a.ws; cx.out = a.out;
    LAS unsigned char* lds = (LAS unsigned char*)smem;
    const int G = gridDim.x;
    unsigned* const gbar = (unsigned*)(a.ws + WS_BAR);
    unsigned bar_round = 0;
    if (a.ph_hi > 1000) cg::this_grid().sync();
    volatile unsigned* const bst = (volatile unsigned*)(smem + STAGE_BYTES);
    if (threadIdx.x == 0) { bst[0] = 0u; bst[1] = 0u; (void)xb_add(&gbar[XB_XCNT(xb_xcc_id())], 1u); }
    __syncthreads();
#define GRID_SYNC() do { ++bar_round; if (bar_round == 1u) grid_barrier(gbar, (unsigned)G); else xcd_barrier(gbar, bst); } while (0)

    for (int ph = a.ph_lo; ph < a.ph_hi; ++ph) {
        cx.ws = a.ws; cx.out = a.out; asm volatile("" : "+s"(cx.ws), "+s"(cx.out));
        int l = 0, k = -1;
        if (ph >= 2) { l = (ph - 2) / 12; k = (ph - 2) % 12; }
        const int nrep = 1 + ((MK_REPEAT_MASK >> (ph == 0 ? 12 : (ph == 1 ? 13 : k))) & 1);
        for (int rep = 0; rep < nrep; ++rep) {
        bool do_gemm = false; GemmCall g; g.A = nullptr; g.Bt = nullptr; g.ld2 = 0; g.gt = 0;
        if (ph == 0) {
            for (int t = blockIdx.x; t < PREP_TILES; t += G) prep_tile(a, 0, t, smem);
            ada_phase(a, cx, smem);
        } else if (ph == 1) {
            ln_phase(a, cx, 0, -1);
        } else {
            switch (k) {
            case 0: do_gemm = true; g.A = (const char*)cx.H(); g.Bt = (const char*)(a.ws + W_FFN1_IN); g.ld2 = 2048; g.gt = GT_FFN_IN; break;
            case 1: do_gemm = true; g.A = (const char*)cx.ACT(); g.Bt = (const char*)(a.ws + W_FFN1_OUT); g.ld2 = 5632; g.gt = GT_FFN_OUT; break;
            case 2: ln_phase(a, cx, l, 0); break;
            case 3: cache_prep(a, cx, l); do_gemm = true; g.A = (const char*)cx.H(); g.Bt = (const char*)(a.ws + W_MIX_IN); g.ld2 = 2048; g.gt = GT_MIX_IN; break;
            case 4:
                conv_rows(a, cx, l, smem);
                ckv_out_rows(a, cx, l);
                for (int u = blockIdx.x; u < 256; u += G) r1_unit(a, cx, l, u, smem);
                do_gemm = true; g.A = (const char*)cx.MQKV(); g.Bt = (const char*)(a.ws + W_M2); g.ld2 = 1536; g.gt = GT_M2;
                if (G >= 240) {
                    Unit u0; const int t = otid();
                    if (sched_next(g, 0, blockIdx.x, G, u0) && t < 256) {
                        const int r = u0.pm * 256 + t; float rs = 1.0f;
                        if (u0.kind == EK_QUP) { const f32x4 s0 = *(const f32x4*)(cx.SSQQ() + (size_t)r * 8), s1 = *(const f32x4*)(cx.SSQQ() + (size_t)r * 8 + 4);
                            rs = rsqrtf((((s0[0] + s0[1]) + (s0[2] + s0[3])) + ((s1[0] + s1[1]) + (s1[2] + s1[3]))) * (1.0f / 512.0f) + 1e-6f) * QSCALE; }
                        else if (u0.kind == EK_KVUP) { const f32x4 s0 = *(const f32x4*)(cx.SSQKV() + (size_t)r * 4); rs = rsqrtf(((s0[0] + s0[1]) + (s0[2] + s0[3])) * (1.0f / 256.0f) + 1e-6f); }
                        *(float*)(smem + RS_OFF + 4 * t) = rs;
                    }
                }
                __syncthreads();
                g.A = (const char*)cx.MQKV(); g.Bt = (const char*)(a.ws + W_M2); g.ld2 = 1536; g.gt = GT_M2; break;
            case 5:
                for (int u = blockIdx.x; u < 256; u += G) r2_unit(a, cx, l, u, smem);
                for (int u = blockIdx.x; u < 512; u += G) attn_unit(cx, u, smem);
                break;
            case 6: do_gemm = true; g.A = (const char*)cx.BR(); g.Bt = (const char*)(a.ws + W_BR); g.ld2 = 4096; g.gt = GT_BR; break;
            case 7: do_gemm = true; g.A = (const char*)cx.MG(); g.Bt = (const char*)(a.ws + W_O2); g.ld2 = 4096; g.gt = GT_MIX_O; break;
            case 8: ln_phase(a, cx, l, 1); break;
            case 9: do_gemm = true; g.A = (const char*)cx.H(); g.Bt = (const char*)(a.ws + W_FFN2_IN); g.ld2 = 2048; g.gt = GT_FFN_IN; break;
            case 10: do_gemm = true; g.A = (const char*)cx.ACT(); g.Bt = (const char*)(a.ws + W_FFN2_OUT); g.ld2 = 5632; g.gt = GT_FFN_OUT; break;
            default:
                ln_phase(a, cx, l, 2);
                if (l == 0) for (int t = blockIdx.x; t < PREP_TILES; t += G) prep_tile(a, 1, t, smem);
                break;
            }
        }
        if (do_gemm) gemm_phase(lds, g, cx, a, l);
        if (rep + 1 < nrep) GRID_SYNC();
        }
        if (ph + 1 < a.ph_hi) GRID_SYNC();
        if ((MK_REPEAT_MASK >> 14) & 1) { if (ph == 5) for (int q = 0; q < 20; ++q) GRID_SYNC(); }
    }
}

constexpr int LDS_BYTES = STAGE_BYTES + 16 + 1024;

extern "C" void kernel_launch(void* const* d_in, const int* in_sizes, int n_in, void* d_out, int out_size, void* d_ws, size_t ws_size, hipStream_t stream) {
    static int grid = 0;
    if (grid == 0) {
        if (n_in != 31 || ws_size < WS_END) { fprintf(stderr, "kernel_launch: unexpected n_in %d or ws_size %zu (< %zu)\n", n_in, ws_size, (size_t)WS_END); grid = -1; return; }
        int dev = 0, cus = 0, per_cu = 0;
        hipGetDevice(&dev);
        hipDeviceGetAttribute(&cus, hipDeviceAttributeMultiprocessorCount, dev);
        if (hipFuncSetAttribute((const void*)mk_fwd, hipFuncAttributeMaxDynamicSharedMemorySize, LDS_BYTES) != hipSuccess) { fprintf(stderr, "kernel_launch: hipFuncSetAttribute failed\n"); grid = -1; return; }
        hipOccupancyMaxActiveBlocksPerMultiprocessor(&per_cu, (const void*)mk_fwd, 512, LDS_BYTES);
        (void)hipGetLastError();
        if (per_cu < 1 || cus < 1) { fprintf(stderr, "kernel_launch: per_cu %d cus %d\n", per_cu, cus); grid = -1; return; }
        grid = cus;
    }
    if (grid < 0) return;
    Args a{};
    for (int i = 0; i < 31; ++i) a.in[i] = (const float*)d_in[i];
    a.out = (float*)d_out; a.ws = (unsigned char*)d_ws;
#if MK_PER_PHASE
    for (int ph = 0; ph < MK_PH_HI; ++ph) {
        a.ph_lo = ph; a.ph_hi = ph + MK_DBG_SPAN;
        hipLaunchKernelGGL(mk_fwd, dim3(grid), dim3(512), LDS_BYTES, stream, a);
    }
#else
    a.ph_lo = 0; a.ph_hi = MK_PH_HI;
    (void)hipMemsetAsync((unsigned char*)d_ws + WS_BAR, 0, 16384, stream);
    void* args[] = {&a};
    hipError_t e = hipLaunchCooperativeKernel((const void*)mk_fwd, dim3(grid), dim3(512), args, LDS_BYTES, stream);
    if (e != hipSuccess) fprintf(stderr, "kernel_launch: cooperative launch failed: %s\n", hipGetErrorString(e));
#endif
}
```

```cpp
#include <hip/hip_runtime.h>
#include <hip/hip_cooperative_groups.h>
#include <cstdio>
namespace cg = cooperative_groups;

#ifndef MK_PER_PHASE
#define MK_PER_PHASE 0
#endif
#ifndef MK_DBG_SPAN
#define MK_DBG_SPAN 1
#endif
#ifndef MK_REPEAT_MASK
#define MK_REPEAT_MASK 0
#endif
#ifndef MK_PH_HI
#define MK_PH_HI 26
#endif

#define LAS __attribute__((address_space(3)))
typedef unsigned short bf16_t;
typedef short bf16x8 __attribute__((ext_vector_type(8)));
typedef float f32x4 __attribute__((ext_vector_type(4)));
typedef unsigned u32x4 __attribute__((ext_vector_type(4)));
typedef unsigned u32x2 __attribute__((ext_vector_type(2)));

constexpr int NTOK = 8192;
constexpr float ALPHA = 1.41421356237f;
constexpr float QSCALE = 0.10206207261f * 1.44269504089f;
constexpr int N_PHASES = 26;

constexpr size_t OUT_CKV = 8388608, OUT_KROPE = 10485760, OUT_RF = 10747904, OUT_RB = 14942208;

constexpr size_t MBy = 1u << 20;
constexpr size_t W_FFN1_IN = 0, W_FFN1_OUT = 11534336, W_FFN2_IN = 17301504, W_FFN2_OUT = 28835840, W_MIX_IN = 34603008,
                 W_M2 = 51380224, W_BR = 55705600, W_O2 = 59899904;
constexpr size_t WS_MOD = 62 * MBy, WS_SSQQ = 62 * MBy + 512 * 1024, WS_SSQKV = 62 * MBy + 768 * 1024;
constexpr size_t WS_BAR = 62 * MBy + 960 * 1024;
constexpr size_t WS_Z1 = 63 * MBy, WS_ACT = WS_Z1, WS_H = WS_Z1 + 48 * MBy, WS_KVT = WS_Z1;
constexpr size_t WS_Z2 = 127 * MBy, WS_F = WS_Z2, WS_BR = WS_Z2, WS_SCR = WS_Z2 + 32 * MBy, WS_Q = WS_Z2 + 32 * MBy,
                 WS_KN = WS_Z2 + 45 * MBy, WS_VT = WS_Z2 + 54 * MBy, WS_KROPE = WS_Z2 + 63 * MBy;
constexpr size_t WS_Z3 = 191 * MBy, WS_HGLU = WS_Z3, WS_QR = WS_Z3 + 8 * MBy, WS_KR = WS_Z3 + 16 * MBy, WS_KRT = WS_Z3 + 24 * MBy,
                 WS_VRT = WS_Z3 + 32 * MBy, WS_GR = WS_Z3 + 48 * MBy, WS_MQKV = WS_Z3 + 64 * MBy, WS_MG = WS_Z3;
constexpr size_t WS_BG = 269 * MBy, WS_S0T = 317 * MBy, WS_END = 321 * MBy;

struct Args {
    const float* in[31];
    float* out;
    unsigned char* ws;
    int ph_lo, ph_hi;
};
enum { I_XP = 0, I_XS, I_CKV, I_CKR, I_SF, I_SB, I_C, I_CCTX, I_ADAW, I_ADAB, I_F1IN, I_F1OUT, I_F2IN, I_F2OUT, I_LNG, I_LNB, I_MIXIN,
       I_CWDW, I_CBDW, I_CLNG, I_CLNB, I_CWOUT, I_RDF, I_RDB, I_RWOUT, I_QNORM, I_WUQ, I_KVNORM, I_WUKV, I_MWOUT, I_WO };

typedef float f32x2_t __attribute__((ext_vector_type(2)));
typedef __bf16 bf16x2_t __attribute__((ext_vector_type(2)));
__device__ __forceinline__ unsigned cvt_pk_bf16(float lo, float hi) { const f32x2_t v = {lo, hi}; return __builtin_bit_cast(unsigned, __builtin_convertvector(v, bf16x2_t)); }
__device__ __forceinline__ bf16_t f2bf(float x) { return (bf16_t)(cvt_pk_bf16(x, 0.f) & 0xffffu); }
__device__ __forceinline__ float bflo(unsigned w) { return __uint_as_float(w << 16); }
__device__ __forceinline__ float bfhi(unsigned w) { return __uint_as_float(w & 0xffff0000u); }
__device__ __forceinline__ float sigm(float x) { return __builtin_amdgcn_rcpf(1.0f + __expf(-x)); }
__device__ __forceinline__ float silu(float x) { return x * sigm(x); }
__device__ __forceinline__ float wave_sum(float v) {
#pragma unroll
    for (int o = 32; o >= 1; o >>= 1) v += __shfl_xor(v, o);
    return v;
}
__device__ __forceinline__ u32x2 pack4(f32x4 v) { u32x2 w; w.x = cvt_pk_bf16(v[0], v[1]); w.y = cvt_pk_bf16(v[2], v[3]); return w; }
__device__ __forceinline__ f32x4 unpack4(u32x2 w) { return (f32x4){bflo(w.x), bfhi(w.x), bflo(w.y), bfhi(w.y)}; }
union FragU { u32x4 u; bf16x8 v; };
__device__ __forceinline__ u32x4 pack8(f32x4 a, f32x4 b) { u32x4 w; w.x = cvt_pk_bf16(a[0], a[1]); w.y = cvt_pk_bf16(a[2], a[3]); w.z = cvt_pk_bf16(b[0], b[1]); w.w = cvt_pk_bf16(b[2], b[3]); return w; }
__device__ __forceinline__ int perm32(int rho) { const int n = rho >> 4, i = rho & 15; return 8 * (i >> 2) + 4 * n + (i & 3); }
__device__ __forceinline__ bf16x8 ldfrag(const bf16_t* p) { return *(const bf16x8*)p; }
#define MFMA16(a, b, c) __builtin_amdgcn_mfma_f32_16x16x32_bf16((a), (b), (c), 0, 0, 0)

__device__ __forceinline__ int otid() { int t = threadIdx.x; asm volatile("" : "+v"(t)); return t; }
struct Ctx {
    unsigned char* ws; float* out;
#define CXP(name, type, off) __device__ __forceinline__ type* name() const { return (type*)(ws + (off)); }
    CXP(MOD, float, WS_MOD) CXP(SSQQ, float, WS_SSQQ) CXP(SSQKV, float, WS_SSQKV) CXP(ACT, bf16_t, WS_ACT) CXP(H, bf16_t, WS_H) CXP(KVT, float, WS_KVT)
    CXP(F, float, WS_F) CXP(BR, bf16_t, WS_BR) CXP(SCR, float, WS_SCR) CXP(Q, bf16_t, WS_Q) CXP(HGLU, bf16_t, WS_HGLU) CXP(QR, bf16_t, WS_QR)
    CXP(KR, bf16_t, WS_KR) CXP(KRT, bf16_t, WS_KRT) CXP(VRT, bf16_t, WS_VRT) CXP(GR, bf16_t, WS_GR) CXP(MQKV, bf16_t, WS_MQKV) CXP(MG, bf16_t, WS_MG)
    CXP(BG, bf16_t, WS_BG) CXP(KN, bf16_t, WS_KN) CXP(VT, bf16_t, WS_VT) CXP(KROPE, bf16_t, WS_KROPE) CXP(S0T, float, WS_S0T)
#undef CXP
};

constexpr int BM = 256, BK = 64, HALF = 128, HTB = HALF * BK * 2, STAGE_BYTES = 8 * HTB;
constexpr int RS_OFF = STAGE_BYTES + 16;
__device__ __forceinline__ int lds_byte(int r, int c) { const int st = (r >> 4) * 2 + (c >> 5), rr = r & 15, cc = c & 31, ob = rr * 64 + cc * 2; return st * 1024 + (ob ^ (((ob >> 9) & 1) << 5)); }
__device__ __forceinline__ void stage_rc(int b, int& R, int& C) { const int st = b / 1024, sb = b % 1024, swz = sb ^ (((sb >> 9) & 1) << 5); R = (st >> 1) * 16 + swz / 64; C = (st & 1) * 32 + (swz % 64) / 2; }

enum { GT_FFN_IN = 0, GT_FFN_OUT, GT_MIX_IN, GT_M2, GT_BR, GT_MIX_O };
enum { EK_SWIGLU = 0, EK_F32, EK_MIXIN, EK_QUP, EK_KVUP, EK_KVC, EK_BR0, EK_BR1, EK_BR2 };
struct Unit { size_t aoff, boff; int nt, kind, pm, pn, kz; };
struct GemmCall { const char* A; const char* Bt; unsigned ld2; int gt; };

__device__ __forceinline__ void tile_order(int L, int nM, int nN, int& pm, int& pn) {
    const int nwg = nM * nN; int wgid = L;
    { const int q = nwg / 8, r = nwg % 8, xcd = wgid % 8, off = wgid / 8; wgid = (xcd < r ? xcd * (q + 1) : r * (q + 1) + (xcd - r) * q) + off; }
    const int nig = 8 * nN, gid = wgid / nig, fm = gid * 8, gsz = (nM - fm) < 8 ? (nM - fm) : 8;
    pm = fm + ((wgid % nig) % gsz); pn = (wgid % nig) / gsz;
}

__device__ __forceinline__ bool sched_next(const GemmCall& g, int i, int c, int G, Unit& u) {
    const int L = i * G + c;
    u.kz = 0;
    switch (g.gt) {
    case GT_FFN_IN: {
        if (L >= 32 * 22) return false;
        int pm, pn; tile_order(L, 32, 22, pm, pn);
        u.pm = pm; u.pn = pn; u.nt = 16; u.kind = EK_SWIGLU; u.aoff = (size_t)pm * 256 * g.ld2; u.boff = (size_t)pn * 256 * g.ld2; return true; }
    case GT_FFN_OUT: {
        if (L >= 256) return false;
        int pm, pe; tile_order(L, 32, 8, pm, pe);
        u.pm = pm; u.pn = pe >> 1; u.kz = pe & 1; u.nt = 22; u.kind = EK_F32;
        u.aoff = (size_t)pm * 256 * g.ld2 + (size_t)u.kz * 1408 * 2; u.boff = (size_t)u.pn * 256 * g.ld2 + (size_t)u.kz * 1408 * 2; return true; }
    case GT_MIX_IN: {
        if (L >= 1024) return false;
        int pm, pn; tile_order(L, 32, 32, pm, pn);
        u.pm = pm; u.pn = pn; u.nt = 16; u.kind = EK_MIXIN; u.aoff = (size_t)pm * 256 * g.ld2; u.boff = (size_t)pn * 256 * g.ld2; return true; }
    case GT_M2: {
        if (L >= 240) return false;
        if (L < 96) { u.pm = L & 31; u.pn = L >> 5; u.nt = 8; u.kind = EK_QUP; u.aoff = (size_t)u.pm * 256 * g.ld2; u.boff = (size_t)u.pn * 256 * g.ld2; }
        else if (L < 224) { const int t = L - 96; u.pm = t & 31; u.pn = t >> 5; u.nt = 4; u.kind = EK_KVUP; u.aoff = (size_t)u.pm * 256 * g.ld2 + 512 * 2; u.boff = (size_t)(768 + u.pn * 256) * g.ld2; }
        else { const int t = L - 224; u.pm = t & 3; u.pn = t >> 2; u.nt = 4; u.kind = EK_KVC; u.aoff = (size_t)(8192 + u.pm * 256) * g.ld2 + 512 * 2; u.boff = (size_t)(1792 + u.pn * 256) * g.ld2; }
        return true; }
    case GT_BR: {
        int rem = i, slot = -1;
        for (int j = 0;; ++j) { const int sl = j * G + c; if (sl >= 256) return false; const int n = sl < 128 ? 1 : 2; if (rem < n) { slot = sl; break; } rem -= n; }
        if (slot < 128) { u.pm = slot & 31; u.pn = slot >> 5; u.nt = 16; u.kind = EK_BR1; u.aoff = (size_t)u.pm * 256 * g.ld2; u.boff = (size_t)u.pn * 256 * g.ld2; return true; }
        { const int t = slot - 128; u.pm = t & 31; u.pn = t >> 5; u.nt = 8; const int koff = (rem == 0) ? 1024 : 1536; u.kind = (rem == 0) ? EK_BR0 : EK_BR2;
          u.aoff = (size_t)u.pm * 256 * g.ld2 + (size_t)koff * 2; u.boff = (size_t)u.pn * 256 * g.ld2 + (size_t)koff * 2; }
        return true; }
    default: {
        if (L >= 256) return false;
        int pm, pe; tile_order(L, 32, 8, pm, pe);
        u.pm = pm; u.pn = pe >> 1; u.kz = pe & 1; u.nt = 16; u.kind = EK_F32;
        u.aoff = (size_t)pm * 256 * g.ld2 + (size_t)u.kz * 1024 * 2; u.boff = (size_t)u.pn * 256 * g.ld2 + (size_t)u.kz * 1024 * 2; return true; }
    }
}

__device__ __forceinline__ void rope4(f32x4& x1, f32x4& x2, int t, int fq) {
    const float pos = (float)((fq >> 1) ? (t & 63) : (t >> 6));
#pragma unroll
    for (int j = 0; j < 4; ++j) {
        const float fi = (float)(4 * (fq & 1) + j);
        const float ang = pos * exp2f(-fi * 1.6609640474f);
        const float cs = __cosf(ang), sn = __sinf(ang);
        const float a = x1[j], b = x2[j];
        x1[j] = a * cs - b * sn; x2[j] = a * sn + b * cs;
    }
}

__device__ __forceinline__ void epilogue(const Ctx& cx, const Args& a, int l, const f32x4 (&acc)[2][2][4][2], const Unit& u, LAS unsigned char* lds) {
    const int tid_e = otid(), wid_e = __builtin_amdgcn_readfirstlane(tid_e >> 6), wr = wid_e >> 2, wc = wid_e & 3, fr = tid_e & 15, fq = (tid_e & 63) >> 4;
    const int row0 = u.pm * 256 + wr * 64 + fr;
    const int cin0 = wc * 32 + 4 * fq;
    const int cP = wc * 32 + 8 * fq;
    switch (u.kind) {
    case EK_SWIGLU: {
#pragma unroll
        for (int ai = 0; ai < 2; ++ai)
#pragma unroll
            for (int m = 0; m < 4; ++m) {
                const int r = row0 + ai * 128 + m * 16;
                bf16_t* rowp = cx.ACT() + (size_t)r * 2816 + u.pn * 128 + cP;
                f32x4 v[2];
#pragma unroll
                for (int n = 0; n < 2; ++n) {
                    const f32x4 g = acc[ai][0][m][n], up = acc[ai][1][m][n];
#pragma unroll
                    for (int j = 0; j < 4; ++j) v[n][j] = silu(g[j]) * up[j];
                }
                *(u32x4*)rowp = pack8(v[0], v[1]);
            }
    } break;
    case EK_F32: {
#pragma unroll
        for (int ai = 0; ai < 2; ++ai)
#pragma unroll
            for (int m = 0; m < 4; ++m) {
                const int r = row0 + ai * 128 + m * 16;
                bf16_t* rowp = (bf16_t*)cx.F() + ((size_t)u.kz * NTOK + r) * 1024 + u.pn * 256 + cP;
#pragma unroll
                for (int bj = 0; bj < 2; ++bj) *(u32x4*)(rowp + bj * 128) = pack8(acc[ai][bj][m][0], acc[ai][bj][m][1]);
            }
    } break;
    case EK_MIXIN: {
        const int pn = u.pn;
        const int rowbase = (u.pm < 16) ? u.pm * 256 : 4096 + ((u.pm - 16) >> 2) * 1024;
        const int T = (u.pm < 16) ? 256 : 1024;
        if (pn < 4) {
#pragma unroll
            for (int ai = 0; ai < 2; ++ai)
#pragma unroll
                for (int m = 0; m < 4; ++m) {
                    const int r = row0 + ai * 128 + m * 16;
                    bf16_t* rowp = cx.HGLU() + (size_t)r * 512 + pn * 128 + cP;
                    f32x4 v[2];
#pragma unroll
                    for (int n = 0; n < 2; ++n) {
                        const f32x4 av = acc[ai][0][m][n], g = acc[ai][1][m][n];
#pragma unroll
                        for (int j = 0; j < 4; ++j) v[n][j] = av[j] * sigm(g[j]);
                    }
                    *(u32x4*)rowp = pack8(v[0], v[1]);
                }
        } else if (pn < 6) {
#pragma unroll
            for (int ai = 0; ai < 2; ++ai)
#pragma unroll
                for (int m = 0; m < 4; ++m) {
                    const int r = row0 + ai * 128 + m * 16;
                    bf16_t* rowp = cx.QR() + (size_t)r * 512 + (pn - 4) * 256 + cP;
#pragma unroll
                    for (int bj = 0; bj < 2; ++bj) *(u32x4*)(rowp + bj * 128) = pack8(acc[ai][bj][m][0], acc[ai][bj][m][1]);
                }
        } else if (pn < 8) {
            bf16_t* tb = cx.KRT() + (size_t)rowbase * 512;
#pragma unroll
            for (int ai = 0; ai < 2; ++ai)
#pragma unroll
                for (int m = 0; m < 4; ++m) {
                    const int r = row0 + ai * 128 + m * 16;
                    bf16_t* rowp = cx.KR() + (size_t)r * 512 + (pn - 6) * 256 + cin0;
#pragma unroll
                    for (int bj = 0; bj < 2; ++bj)
#pragma unroll
                        for (int n = 0; n < 2; ++n) {
                            const f32x4 v = acc[ai][bj][m][n] * 0.08838834764f;
                            const u32x2 w = pack4(v);
                            *(u32x2*)(rowp + bj * 128 + n * 16) = w;
                            const int col = (pn - 6) * 256 + bj * 128 + n * 16 + cin0;
                            bf16_t* tp = tb + (size_t)col * T + (r - rowbase);
                            tp[0] = (bf16_t)(w.x & 0xffffu); tp[(size_t)T] = (bf16_t)(w.x >> 16); tp[(size_t)2 * T] = (bf16_t)(w.y & 0xffffu); tp[(size_t)3 * T] = (bf16_t)(w.y >> 16);
                        }
                }
        } else if (pn < 12) {
            bf16_t* tb = cx.VRT() + (size_t)rowbase * 1024;
#pragma unroll
            for (int ai = 0; ai < 2; ++ai)
#pragma unroll
                for (int m = 0; m < 4; ++m) {
                    const int r = row0 + ai * 128 + m * 16;
#pragma unroll
                    for (int bj = 0; bj < 2; ++bj)
#pragma unroll
                        for (int n = 0; n < 2; ++n) {
                            const u32x2 w = pack4(acc[ai][bj][m][n]);
                            const int col = (pn - 8) * 256 + bj * 128 + n * 16 + cin0;
                            bf16_t* tp = tb + (size_t)col * T + (r - rowbase);
                            tp[0] = (bf16_t)(w.x & 0xffffu); tp[(size_t)T] = (bf16_t)(w.x >> 16); tp[(size_t)2 * T] = (bf16_t)(w.y & 0xffffu); tp[(size_t)3 * T] = (bf16_t)(w.y >> 16);
                        }
                }
        } else if (pn < 16) {
#pragma unroll
            for (int ai = 0; ai < 2; ++ai)
#pragma unroll
                for (int m = 0; m < 4; ++m) {
                    const int r = row0 + ai * 128 + m * 16;
                    bf16_t* rowp = cx.GR() + (size_t)r * 1024 + (pn - 12) * 256 + cP;
#pragma unroll
                    for (int bj = 0; bj < 2; ++bj) { f32x4 v[2];
#pragma unroll
                        for (int n = 0; n < 2; ++n) { const f32x4 x = acc[ai][bj][m][n];
#pragma unroll
                            for (int j = 0; j < 4; ++j) v[n][j] = silu(x[j]); }
                        *(u32x4*)(rowp + bj * 128) = pack8(v[0], v[1]); }
                }
        } else if (pn < 19) {
            const bool isq = pn < 18;
#pragma unroll
            for (int ai = 0; ai < 2; ++ai)
#pragma unroll
                for (int m = 0; m < 4; ++m) {
                    const int r = row0 + ai * 128 + m * 16;
                    bf16_t* rowp = cx.MQKV() + (size_t)r * 768 + (pn - 16) * 256 + cin0;
                    float s = 0.f;
#pragma unroll
                    for (int bj = 0; bj < 2; ++bj)
#pragma unroll
                        for (int n = 0; n < 2; ++n) { const f32x4 x = acc[ai][bj][m][n]; s += (x[0] * x[0] + x[1] * x[1]) + (x[2] * x[2] + x[3] * x[3]);
                            *(u32x2*)(rowp + bj * 128 + n * 16) = pack4(x); }
                    s += __shfl_xor(s, 16); s += __shfl_xor(s, 32);
                    if (fq == 0) { if (isq) cx.SSQQ()[(size_t)r * 8 + (pn - 16) * 4 + wc] = s; else cx.SSQKV()[(size_t)r * 4 + wc] = s; }
                    if (!isq && r < 4096) {
                        float* o = cx.out + OUT_CKV + ((size_t)((r >> 8) * 2 + l) * 256 + (r & 255)) * 256 + cin0;
#pragma unroll
                        for (int bj = 0; bj < 2; ++bj)
#pragma unroll
                            for (int n = 0; n < 2; ++n) *(f32x4*)(o + bj * 128 + n * 16) = acc[ai][bj][m][n];
                    }
                }
        } else if (pn == 19) {
            if (wc == 0) {
#pragma unroll
                for (int ai = 0; ai < 2; ++ai)
#pragma unroll
                    for (int m = 0; m < 4; ++m) {
                        const int r = row0 + ai * 128 + m * 16;
                        f32x4 x1 = acc[ai][0][m][0], x2 = acc[ai][0][m][1];
                        size_t kr;
                        if (r < 4096) {
                            float* o = cx.out + OUT_KROPE + ((size_t)((r >> 8) * 2 + l) * 256 + (r & 255)) * 32 + (fq >> 1) * 16 + 4 * (fq & 1);
                            *(f32x4*)(o) = x1; *(f32x4*)(o + 8) = x2;
                            kr = (size_t)r;
                        } else {
                            const int rr = r - 4096, t = rr & 1023;
                            rope4(x1, x2, t, fq);
                            kr = (size_t)4096 + (size_t)(rr >> 10) * 1280 + 256 + t;
                        }
                        bf16_t* kp = cx.KROPE() + kr * 32 + 4 * fq;
                        *(u32x2*)(kp) = pack4(x1); *(u32x2*)(kp + 16) = pack4(x2);
                    }
            }
        } else {
#pragma unroll
            for (int ai = 0; ai < 2; ++ai)
#pragma unroll
                for (int m = 0; m < 4; ++m) {
                    const int r = row0 + ai * 128 + m * 16;
                    bf16_t* rowp = cx.BG() + (size_t)r * 3072 + (pn - 20) * 256 + cP;
#pragma unroll
                    for (int bj = 0; bj < 2; ++bj) { f32x4 v[2];
#pragma unroll
                        for (int n = 0; n < 2; ++n) { const f32x4 x = acc[ai][bj][m][n];
#pragma unroll
                            for (int j = 0; j < 4; ++j) v[n][j] = sigm(x[j]); }
                        *(u32x4*)(rowp + bj * 128) = pack8(v[0], v[1]); }
                }
        }
    } break;
    case EK_QUP: {
#pragma unroll
        for (int ai = 0; ai < 2; ++ai)
#pragma unroll
            for (int m = 0; m < 4; ++m) {
                const int r = row0 + ai * 128 + m * 16;
                float rs;
                if (gridDim.x >= 240) rs = *(const LAS float*)(lds + RS_OFF + 4 * (wr * 64 + fr + ai * 128 + m * 16));
                else { const f32x4 s0 = *(const f32x4*)(cx.SSQQ() + (size_t)r * 8), s1 = *(const f32x4*)(cx.SSQQ() + (size_t)r * 8 + 4);
                       rs = rsqrtf((((s0[0] + s0[1]) + (s0[2] + s0[3])) + ((s1[0] + s1[1]) + (s1[2] + s1[3]))) * (1.0f / 512.0f) + 1e-6f) * QSCALE; }
                bf16_t* qrow = cx.Q() + (size_t)r * 768;
                if (u.pn < 2) {
#pragma unroll
                    for (int bj = 0; bj < 2; ++bj)
#pragma unroll
                        for (int n = 0; n < 2; ++n) {
                            const int col = u.pn * 256 + bj * 128 + n * 16 + cin0;
                            *(u32x2*)(qrow + (col >> 6) * 96 + (col & 63)) = pack4(acc[ai][bj][m][n] * rs);
                        }
                } else {
#pragma unroll
                    for (int bj = 0; bj < 2; ++bj) {
                        f32x4 x1 = acc[ai][bj][m][0] * rs, x2 = acc[ai][bj][m][1] * rs;
                        if (r >= 4096) rope4(x1, x2, (r - 4096) & 1023, fq);
                        bf16_t* qp = qrow + (4 * bj + wc) * 96 + 64 + 4 * fq;
                        *(u32x2*)(qp) = pack4(x1); *(u32x2*)(qp + 16) = pack4(x2);
                    }
                }
            }
    } break;
    case EK_KVUP:
    case EK_KVC: {
        const bool cache = (u.kind == EK_KVC);
        int kbase, Tk, joff;
        if (cache) { kbase = 4096 + 1280 * u.pm; Tk = 1280; joff = 0; }
        else if (u.pm < 16) { kbase = 256 * u.pm; Tk = 256; joff = 0; }
        else { const int b = (u.pm - 16) >> 2; kbase = 4096 + 1280 * b; Tk = 1280; joff = 256 + ((u.pm - 16) & 3) * 256; }
#pragma unroll
        for (int ai = 0; ai < 2; ++ai)
#pragma unroll
            for (int m = 0; m < 4; ++m) {
                const int lr_ = wr * 64 + fr + ai * 128 + m * 16;
                const int r = u.pm * 256 + lr_;
                float rs = 1.0f;
                if (!cache) {
                    if (gridDim.x >= 240) rs = *(const LAS float*)(lds + RS_OFF + 4 * lr_);
                    else { const f32x4 s0 = *(const f32x4*)(cx.SSQKV() + (size_t)r * 4); rs = rsqrtf(((s0[0] + s0[1]) + (s0[2] + s0[3])) * (1.0f / 256.0f) + 1e-6f); }
                }
                const int jpos = joff + lr_;
#pragma unroll
                for (int bj = 0; bj < 2; ++bj) {
                    const int head = 2 * u.pn + bj;
#pragma unroll
                    for (int n = 0; n < 2; ++n) {
                        const u32x2 w = pack4(acc[ai][bj][m][n] * rs);
                        if (wc < 2) {
                            *(u32x2*)(cx.KN() + (size_t)(kbase + jpos) * 512 + head * 64 + wc * 32 + n * 16 + 4 * fq) = w;
                        } else {
                            const int dv = (wc - 2) * 32 + n * 16 + 4 * fq;
                            bf16_t* tp = cx.VT() + (size_t)kbase * 512 + (size_t)(head * 64 + dv) * Tk + jpos;
                            tp[0] = (bf16_t)(w.x & 0xffffu); tp[(size_t)Tk] = (bf16_t)(w.x >> 16); tp[(size_t)2 * Tk] = (bf16_t)(w.y & 0xffffu); tp[(size_t)3 * Tk] = (bf16_t)(w.y >> 16);
                        }
                    }
                }
            }
    } break;
    case EK_BR0:
    case EK_BR1:
    case EK_BR2: {
        const int gofs = (u.kind == EK_BR0) ? 0 : (u.kind == EK_BR1 ? 1024 : 2048);
        __builtin_assume_separate_storage(cx.BG(), cx.MG()); __builtin_assume_separate_storage(cx.BG(), cx.SCR()); __builtin_assume_separate_storage(cx.SCR(), cx.MG());
#pragma unroll
        for (int ai = 0; ai < 2; ++ai)
#pragma unroll
            for (int m = 0; m < 4; ++m) {
                const int r = row0 + ai * 128 + m * 16;
                const int colb = u.pn * 256 + cP;
                u32x4 gw[2]; u32x4 sv[2];
#pragma unroll
                for (int bj = 0; bj < 2; ++bj) {
                    gw[bj] = *(const u32x4*)(cx.BG() + (size_t)r * 3072 + gofs + colb + bj * 128);
                    if (u.kind == EK_BR2) sv[bj] = *(const u32x4*)((const bf16_t*)cx.SCR() + (size_t)r * 1024 + colb + bj * 128);
                }
#pragma unroll
                for (int bj = 0; bj < 2; ++bj) {
                    const int col = colb + bj * 128;
                    const f32x4 g0 = (f32x4){bflo(gw[bj].x), bfhi(gw[bj].x), bflo(gw[bj].y), bfhi(gw[bj].y)}, g1 = (f32x4){bflo(gw[bj].z), bfhi(gw[bj].z), bflo(gw[bj].w), bfhi(gw[bj].w)};
                    f32x4 v0 = acc[ai][bj][m][0] * g0, v1 = acc[ai][bj][m][1] * g1;
                    if (u.kind == EK_BR0) { *(u32x4*)((bf16_t*)cx.SCR() + (size_t)r * 1024 + col) = pack8(v0, v1); }
                    else if (u.kind == EK_BR1) { *(u32x4*)(cx.MG() + (size_t)r * 2048 + col) = pack8(v0, v1); }
                    else { v0 += (f32x4){bflo(sv[bj].x), bfhi(sv[bj].x), bflo(sv[bj].y), bfhi(sv[bj].y)}; v1 += (f32x4){bflo(sv[bj].z), bfhi(sv[bj].z), bflo(sv[bj].w), bfhi(sv[bj].w)}; *(u32x4*)(cx.MG() + (size_t)r * 2048 + 1024 + col) = pack8(v0, v1); }
                }
            }
    } break;
    default: break;
    }
}

__device__ __forceinline__ void gemm_phase(LAS unsigned char* lds, const GemmCall g, const Ctx& cx, const Args& a, int l) {
    const int tid = otid(), wid = __builtin_amdgcn_readfirstlane(tid >> 6), lane = tid & 63, wr = wid >> 2, wc = wid & 3, fr = lane & 15, fq = lane >> 4;
    const int G = gridDim.x, cidx = blockIdx.x;
    unsigned voffA[2];
#pragma unroll
    for (int i = 0; i < 2; ++i) { int R, C; stage_rc(tid * 16 + i * 8192, R, C); voffA[i] = (unsigned)R * g.ld2 + (unsigned)C * 2u; }
    const size_t kstep = (size_t)(BK * 2);
    const size_t hstepA = (size_t)HALF * g.ld2;
    const unsigned ldsw = (unsigned)wid * 1024u;
    const int aoff = lds_byte(wr * 64 + fr, fq * 8), boff = lds_byte(wc * 32 + fr, fq * 8);
#define PG8_SA(b, h) (((b) * 2 + (h)) * HTB)
#define PG8_SB(b, h) ((4 + (b) * 2 + (h)) * HTB)
#define PG8_STAGE(bufoff, gbase, voff) do { _Pragma("unroll") for (int _i = 0; _i < 2; ++_i) \
        __builtin_amdgcn_global_load_lds((const unsigned*)((const char*)(gbase) + (voff)[_i]), (LAS unsigned*)(lds + (bufoff) + ldsw + _i * 8192), 16, 0, 0); } while (0)
#define PG8_LDA(dst, b, h) do { _Pragma("unroll") for (int m = 0; m < 4; ++m) _Pragma("unroll") for (int k = 0; k < 2; ++k) dst[m][k] = *(const LAS bf16x8*)(lds + PG8_SA(b, h) + aoff + m * 2048 + k * 1024); } while (0)
#define PG8_LDB(dst, b, h) do { _Pragma("unroll") for (int n = 0; n < 2; ++n) _Pragma("unroll") for (int k = 0; k < 2; ++k) dst[n][k] = *(const LAS bf16x8*)(lds + PG8_SB(b, h) + boff + n * 2048 + k * 1024); } while (0)
#define PG8_MMA(ai, bj, At, Bt) do { __builtin_amdgcn_s_setprio(1); _Pragma("unroll") for (int m = 0; m < 4; ++m) _Pragma("unroll") for (int n = 0; n < 2; ++n) _Pragma("unroll") for (int k = 0; k < 2; ++k) \
        acc[ai][bj][m][n] = __builtin_amdgcn_mfma_f32_16x16x32_bf16(Bt[n][k], At[m][k], acc[ai][bj][m][n], 0, 0, 0); __builtin_amdgcn_s_setprio(0); } while (0)
#define PG8_WAIT_V(n) asm volatile("s_waitcnt vmcnt(" #n ")" ::: "memory")
#define PG8_WAIT_L(n) asm volatile("s_waitcnt lgkmcnt(" #n ")" ::: "memory")
#define PG8_BAR __builtin_amdgcn_s_barrier()
#define PG8_SCHED __builtin_amdgcn_sched_barrier(0)
    Unit cur, nxt; int ui = 0;
    if (!sched_next(g, 0, cidx, G, cur)) return;
    f32x4 acc[2][2][4][2];
#pragma unroll
    for (int x = 0; x < 2; ++x)
#pragma unroll
        for (int b = 0; b < 2; ++b)
#pragma unroll
            for (int m = 0; m < 4; ++m)
#pragma unroll
                for (int n = 0; n < 2; ++n) acc[x][b][m][n] = (f32x4){0.f, 0.f, 0.f, 0.f};
    bf16x8 At[4][2], B0[2][2], B1[2][2];
    const char* cA = g.A + cur.aoff; const char* cB = g.Bt + cur.boff;
    PG8_STAGE(PG8_SB(0, 0), cB, voffA); PG8_STAGE(PG8_SA(0, 0), cA, voffA); PG8_STAGE(PG8_SB(0, 1), cB + hstepA, voffA); PG8_STAGE(PG8_SA(0, 1), cA + hstepA, voffA);
    if (wr == 1) PG8_BAR;
    PG8_WAIT_V(4); PG8_BAR;
    PG8_STAGE(PG8_SB(1, 0), cB + kstep, voffA); PG8_STAGE(PG8_SA(1, 0), cA + kstep, voffA); PG8_STAGE(PG8_SB(1, 1), cB + hstepA + kstep, voffA);
    PG8_WAIT_V(6); PG8_BAR;
    for (;;) {
        const bool has_next = sched_next(g, ui + 1, cidx, G, nxt);
        const char* nA = has_next ? g.A + nxt.aoff : cA; const char* nB = has_next ? g.Bt + nxt.boff : cB;
        const int nt = cur.nt;
        for (int t = 0; t < nt; t += 2) {
            const bool last = (t == nt - 2);
            const char* a1 = cA + (size_t)(t + 1) * kstep;
            const char* a2 = last ? nA : cA + (size_t)(t + 2) * kstep; const char* b2 = last ? nB : cB + (size_t)(t + 2) * kstep;
            const char* a3 = a2 + kstep; const char* b3 = b2 + kstep;
            PG8_LDB(B0, 0, 0); PG8_SCHED; PG8_LDA(At, 0, 0); PG8_STAGE(PG8_SA(1, 1), a1 + hstepA, voffA);
            PG8_WAIT_L(8); PG8_BAR; PG8_WAIT_L(0); PG8_MMA(0, 0, At, B0); PG8_BAR; PG8_SCHED;
            PG8_LDB(B1, 0, 1); PG8_STAGE(PG8_SB(0, 0), b2, voffA);
            PG8_BAR; PG8_WAIT_L(0); PG8_MMA(0, 1, At, B1); PG8_BAR;
            PG8_LDA(At, 0, 1); PG8_STAGE(PG8_SA(0, 0), a2, voffA);
            PG8_BAR; PG8_WAIT_L(0); PG8_MMA(1, 0, At, B0); PG8_BAR; PG8_SCHED;
            PG8_STAGE(PG8_SB(0, 1), b2 + hstepA, voffA);
            PG8_WAIT_V(6); PG8_BAR; PG8_MMA(1, 1, At, B1); PG8_BAR;
            PG8_LDB(B0, 1, 0); PG8_SCHED; PG8_LDA(At, 1, 0); PG8_STAGE(PG8_SA(0, 1), a2 + hstepA, voffA);
            PG8_WAIT_L(8); PG8_BAR; PG8_WAIT_L(0); PG8_MMA(0, 0, At, B0); PG8_BAR; PG8_SCHED;
            PG8_LDB(B1, 1, 1); PG8_STAGE(PG8_SB(1, 0), b3, voffA);
            PG8_BAR; PG8_WAIT_L(0); PG8_MMA(0, 1, At, B1); PG8_BAR;
            PG8_LDA(At, 1, 1); PG8_STAGE(PG8_SA(1, 0), a3, voffA);
            PG8_BAR; PG8_WAIT_L(0); PG8_MMA(1, 0, At, B0); PG8_BAR; PG8_SCHED;
            PG8_STAGE(PG8_SB(1, 1), b3 + hstepA, voffA);
            PG8_WAIT_V(6); PG8_BAR; PG8_MMA(1, 1, At, B1); PG8_BAR;
        }
        epilogue(cx, a, l, acc, cur, lds);
        if (!has_next) break;
#pragma unroll
        for (int x = 0; x < 2; ++x)
#pragma unroll
            for (int b = 0; b < 2; ++b)
#pragma unroll
                for (int m = 0; m < 4; ++m)
#pragma unroll
                    for (int n = 0; n < 2; ++n) acc[x][b][m][n] = (f32x4){0.f, 0.f, 0.f, 0.f};
        cur = nxt; cA = nA; cB = nB; ++ui;
    }
    PG8_WAIT_V(0);
    if (wr == 0) PG8_BAR;
    PG8_BAR;
#undef PG8_SA
#undef PG8_SB
#undef PG8_STAGE
#undef PG8_LDA
#undef PG8_LDB
#undef PG8_MMA
#undef PG8_WAIT_V
#undef PG8_WAIT_L
#undef PG8_BAR
#undef PG8_SCHED
}

__device__ __forceinline__ int rope_src(int dp) { const int n = dp >> 4, ip = dp & 15; return (ip >> 3) * 16 + n * 8 + (ip & 7); }
__device__ __forceinline__ int mixin_src_col(int n) {
    const int t = n >> 8, w = n & 255;
    if (t < 4) return (w >> 7) * 512 + t * 128 + (w & 127);
    if (t < 6) return 1024 + (t - 4) * 256 + w;
    if (t < 8) return 1536 + (t - 6) * 256 + w;
    if (t < 12) return 2048 + (t - 8) * 256 + w;
    if (t < 16) return 3072 + (t - 12) * 256 + w;
    if (t < 18) return 4096 + (t - 16) * 256 + w;
    if (t == 18) return 4608 + w;
    if (t == 19) return (w < 32) ? 4864 + rope_src(w) : -1;
    return 4896 + (t - 20) * 256 + w;
}
constexpr int PREP_TILES = 352 + 176 + 352 + 176 + 512 + 24 + 16 + 16 + 128 + 128;

__device__ __forceinline__ void prep_tile(const Args& a, int l, int T, unsigned char* smem) {
    bf16_t* tile = (bf16_t*)smem;
    const int tid = otid(), nn = tid & 63, kq = tid >> 6;
    int job, t = T;
    if (t < 352) job = 0; else if ((t -= 352) < 176) job = 1; else if ((t -= 176) < 352) job = 2; else if ((t -= 352) < 176) job = 3;
    else if ((t -= 176) < 512) job = 4; else if ((t -= 512) < 24) job = 5; else if ((t -= 24) < 16) job = 6; else if ((t -= 16) < 16) job = 7;
    else if ((t -= 16) < 128) job = 8; else { t -= 128; job = 9; }
    const float* src = nullptr; const float* kscale = nullptr; size_t ld = 0; int ksrc0 = 0, col = 0, n0 = 0, k0 = 0; size_t ldd = 0; bf16_t* dst = nullptr;
    unsigned char* W = a.ws;
    switch (job) {
    case 0: case 2: { const int tk = t & 3, tn = t >> 2; n0 = tn * 64; k0 = tk * 256; const int n = ((n0 + nn) & ~31) + perm32((n0 + nn) & 31);
        src = a.in[job == 0 ? I_F1IN : I_F2IN] + (size_t)l * 1024 * 5632; ld = 5632; ksrc0 = k0;
        col = ((n & 255) >> 7) * 2816 + (n >> 8) * 128 + (n & 127); dst = (bf16_t*)(W + (job == 0 ? W_FFN1_IN : W_FFN2_IN)); ldd = 1024; } break;
    case 1: case 3: { const int tk = t % 11, tn = t / 11; n0 = tn * 64; k0 = tk * 256;
        src = a.in[job == 1 ? I_F1OUT : I_F2OUT] + (size_t)l * 2816 * 1024; ld = 1024; ksrc0 = k0; col = ((n0 + nn) & ~31) + perm32((n0 + nn) & 31);
        dst = (bf16_t*)(W + (job == 1 ? W_FFN1_OUT : W_FFN2_OUT)); ldd = 2816; } break;
    case 4: { const int tk = t & 3, tn = t >> 2; n0 = tn * 64; k0 = tk * 256;
        src = a.in[I_MIXIN] + (size_t)l * 1024 * 7968; ld = 7968; ksrc0 = k0; { const int n = n0 + nn, tt = n >> 8; const bool pm_ = (tt < 6) || (tt >= 12 && tt < 16) || (tt >= 20); col = mixin_src_col(pm_ ? (n & ~31) + perm32(n & 31) : n); } dst = (bf16_t*)(W + W_MIX_IN); ldd = 1024; } break;
    case 5: { const int tk = t & 1, tn = t >> 1; n0 = tn * 64; k0 = tk * 256; const int n = n0 + nn, tt = n >> 8, w = n & 255;
        src = a.in[I_WUQ] + (size_t)l * 512 * 768; ld = 768; ksrc0 = k0; kscale = a.in[I_QNORM] + l * 512;
        col = (tt < 2) ? (4 * tt + (w >> 6)) * 96 + (w & 63) : (w >> 5) * 96 + 64 + rope_src(w & 31);
        dst = (bf16_t*)(W + W_M2); ldd = 768; } break;
    case 6: case 7: { n0 = t * 64; k0 = 0;
        src = a.in[I_WUKV] + (size_t)l * 256 * 1024; ld = 1024; ksrc0 = 0; col = n0 + nn; if (job == 6) kscale = a.in[I_KVNORM] + l * 256;
        dst = (bf16_t*)(W + W_M2) + (size_t)(job == 6 ? 768 : 1792) * 768; ldd = 768; } break;
    case 8: { const int tk = t & 7, tn = t >> 3; n0 = tn * 64; k0 = tk * 256; col = ((n0 + nn) & ~31) + perm32((n0 + nn) & 31); ld = 1024;
        if (k0 < 1024) { src = a.in[I_RWOUT] + (size_t)l * 1024 * 1024; ksrc0 = k0; }
        else if (k0 < 1536) { src = a.in[I_CWOUT] + (size_t)l * 512 * 1024; ksrc0 = k0 - 1024; }
        else { src = a.in[I_MWOUT] + (size_t)l * 512 * 1024; ksrc0 = k0 - 1536; }
        dst = (bf16_t*)(W + W_BR); ldd = 2048; } break;
    default: { const int tk = t & 7, tn = t >> 3; n0 = tn * 64; k0 = tk * 256; col = ((n0 + nn) & ~31) + perm32((n0 + nn) & 31); ld = 1024;
        src = a.in[I_WO] + (size_t)l * 1024 * 1024; ksrc0 = k0 & 1023; dst = (bf16_t*)(W + W_O2); ldd = 2048; } break;
    }
    {
        const float* sp = src + (size_t)ksrc0 * ld + (col >= 0 ? col : 0);
        float v0[16], v1[16];
#pragma unroll
        for (int i = 0; i < 16; ++i) { const int kk = 2 * (kq + 8 * i); v0[i] = sp[(size_t)kk * ld]; v1[i] = sp[(size_t)(kk + 1) * ld]; }
#pragma unroll
        for (int i = 0; i < 16; ++i) {
            const int kk = 2 * (kq + 8 * i);
            float x0 = v0[i], x1 = v1[i];
            if (kscale) { x0 *= kscale[ksrc0 + kk]; x1 *= kscale[ksrc0 + kk + 1]; }
            if (col < 0) { x0 = 0.f; x1 = 0.f; }
            *(unsigned*)(tile + nn * 264 + kk) = cvt_pk_bf16(x0, x1);
        }
    }
    __syncthreads();
#pragma unroll
    for (int j = 0; j < 4; ++j) {
        const int idx = tid + 512 * j, nn2 = idx >> 5, kk8 = (idx & 31) * 8;
        *(u32x4*)(dst + (size_t)(n0 + nn2) * ldd + k0 + kk8) = *(const u32x4*)(tile + nn2 * 264 + kk8);
    }
    __syncthreads();
}

__device__ __forceinline__ void ada_phase(const Args& a, const Ctx& cx, unsigned char* smem) {
    float* sl = (float*)smem;
    float* red = (float*)(smem + 20480);
    const int tid = otid();
    for (int e = tid; e < 5 * 1024; e += 512) { const int ci = e >> 10, k = e & 1023; const float x = (ci == 0) ? a.in[I_CCTX][k] : a.in[I_C][(ci - 1) * 1024 + k]; sl[e] = silu(x); }
    __syncthreads();
    const int cgp = tid & 15, kg = tid >> 4;
    for (int task = (int)gridDim.x - 1 - (int)blockIdx.x; task < 288; task += gridDim.x) {
        const int l = task / 144, col0 = (task % 144) * 64;
        f32x4 acc[5];
#pragma unroll
        for (int ci = 0; ci < 5; ++ci) acc[ci] = (f32x4){0.f, 0.f, 0.f, 0.f};
        const float* wp = a.in[I_ADAW] + ((size_t)l * 1024 + kg * 32) * 9216 + col0 + cgp * 4;
#pragma unroll 4
        for (int kk = 0; kk < 32; ++kk) {
            const f32x4 w = *(const f32x4*)(wp + (size_t)kk * 9216);
#pragma unroll
            for (int ci = 0; ci < 5; ++ci) acc[ci] += w * sl[ci * 1024 + kg * 32 + kk];
        }
#pragma unroll
        for (int ci = 0; ci < 5; ++ci) *(f32x4*)(red + (kg * 5 + ci) * 64 + cgp * 4) = acc[ci];
        __syncthreads();
        if (tid < 320) {
            const int ci = tid >> 6, cc = tid & 63; float s = 0.f;
            for (int k2 = 0; k2 < 32; ++k2) s += red[(k2 * 5 + ci) * 64 + cc];
            cx.MOD()[((size_t)l * 5 + ci) * 9216 + col0 + cc] = s + a.in[I_ADAB][(size_t)l * 9216 + col0 + cc];
        }
        __syncthreads();
    }
}

#ifndef LN_NR
#define LN_NR 4
#endif
__device__ __forceinline__ void ln_phase(const Args& a, const Ctx& cx, int l, int s) {
    const int tid_ = otid(), lane = tid_ & 63, wave = tid_ >> 6;
    float* X = cx.out;
    const int nl = (s < 0) ? 0 : (s == 2 ? l + 1 : l), nm = (s < 0) ? 0 : (s == 2 ? 0 : 3 * (s + 1));
    const bool have_h = (nl < 2);
    const int rstride = gridDim.x * 8;
    for (int row0 = blockIdx.x * 8 + wave; row0 < NTOK; row0 += LN_NR * rstride) {
        f32x4 xn[LN_NR][4];
        int rows[LN_NR], cis[LN_NR];
#pragma unroll
        for (int rr = 0; rr < LN_NR; ++rr) { int r = row0 + rr * rstride; if (r >= NTOK) r = row0; rows[rr] = r; cis[rr] = r < 4096 ? 0 : 1 + ((r - 4096) >> 10); }
        if (s < 0) {
#pragma unroll
            for (int rr = 0; rr < LN_NR; ++rr) {
                const int row = rows[rr];
                const float* xp = (row < 4096) ? a.in[I_XP] + (size_t)row * 1024 : a.in[I_XS] + (size_t)(row - 4096) * 1024;
#pragma unroll
                for (int q = 0; q < 4; ++q) xn[rr][q] = *(const f32x4*)(xp + q * 256 + lane * 4);
            }
        } else {
            const float gs = (s == 1) ? 1.0f : 0.5f;
            float sum[LN_NR]; for (int rr = 0; rr < LN_NR; ++rr) sum[rr] = 0.f;
#pragma unroll
            for (int rr = 0; rr < LN_NR; ++rr) {
                const int row = rows[rr];
                const float* modl = cx.MOD() + ((size_t)l * 5 + cis[rr]) * 9216 + (3 * s + 2) * 1024;
                const float* xres = (l == 0 && s == 0) ? ((row < 4096) ? a.in[I_XP] + (size_t)row * 1024 : a.in[I_XS] + (size_t)(row - 4096) * 1024) : X + (size_t)row * 1024;
                const bf16_t* f0 = (const bf16_t*)cx.F() + (size_t)row * 1024; const bf16_t* f1 = (const bf16_t*)cx.F() + ((size_t)NTOK + row) * 1024;
#pragma unroll
                for (int q = 0; q < 4; ++q) {
                    const int c = q * 256 + lane * 4;
                    const f32x4 xo = *(const f32x4*)(xres + c), g = *(const f32x4*)(modl + c), p0 = unpack4(*(const u32x2*)(f0 + c)), p1 = unpack4(*(const u32x2*)(f1 + c));
                    xn[rr][q] = xo * ALPHA + (g * gs) * (p0 + p1);
                    sum[rr] += (xn[rr][q][0] + xn[rr][q][1]) + (xn[rr][q][2] + xn[rr][q][3]);
                }
            }
            const float* lg = a.in[I_LNG] + (size_t)(l * 3 + s) * 1024; const float* lb = a.in[I_LNB] + (size_t)(l * 3 + s) * 1024;
#pragma unroll
            for (int rr = 0; rr < LN_NR; ++rr) {
                const float mean = wave_sum(sum[rr]) * (1.0f / 1024.0f);
                float sq = 0.f;
#pragma unroll
                for (int q = 0; q < 4; ++q) { xn[rr][q] = xn[rr][q] - mean; sq += (xn[rr][q][0] * xn[rr][q][0] + xn[rr][q][1] * xn[rr][q][1]) + (xn[rr][q][2] * xn[rr][q][2] + xn[rr][q][3] * xn[rr][q][3]); }
                const float rstd = rsqrtf(wave_sum(sq) * (1.0f / 1024.0f) + 1e-5f);
#pragma unroll
                for (int q = 0; q < 4; ++q) {
                    const int c = q * 256 + lane * 4;
                    xn[rr][q] = xn[rr][q] * rstd * *(const f32x4*)(lg + c) + *(const f32x4*)(lb + c);
                    *(f32x4*)(X + (size_t)rows[rr] * 1024 + c) = xn[rr][q];
                }
            }
        }
        if (have_h) {
#pragma unroll
            for (int rr = 0; rr < LN_NR; ++rr) {
                const float* mn = cx.MOD() + ((size_t)nl * 5 + cis[rr]) * 9216 + nm * 1024;
#pragma unroll
                for (int q = 0; q < 4; ++q) {
                    const int c = q * 256 + lane * 4;
                    const f32x4 sh = *(const f32x4*)(mn + c), sc = *(const f32x4*)(mn + 1024 + c);
                    *(u32x2*)(cx.H() + (size_t)rows[rr] * 1024 + c) = pack4(xn[rr][q] * (sc + 1.0f) + sh);
                }
            }
        }
    }
}

__device__ __forceinline__ void cache_prep(const Args& a, const Ctx& cx, int l) {
    const size_t gtid = (size_t)blockIdx.x * 512 + otid(), gsz = (size_t)gridDim.x * 512;
    for (size_t e = gtid; e < 1024 * 64; e += gsz) {
        const int rr = (int)(e >> 6), c4 = (int)(e & 63) * 4, b = rr >> 8, t = rr & 255;
        const f32x4 v = *(const f32x4*)(a.in[I_CKV] + (((size_t)b * 2 + l) * 256 + t) * 256 + c4);
        *(u32x2*)(cx.MQKV() + (size_t)(8192 + rr) * 768 + 512 + c4) = pack4(v);
    }
    for (size_t e = gtid; e < 1024 * 32; e += gsz) {
        const int rr = (int)(e >> 5), dp = (int)(e & 31), b = rr >> 8, t = rr & 255;
        const float v = a.in[I_CKR][(((size_t)b * 2 + l) * 256 + t) * 32 + rope_src(dp)];
        cx.KROPE()[(size_t)(4096 + 1280 * b + t) * 32 + dp] = f2bf(v);
    }
    for (size_t e = gtid; e < (size_t)16 * 2 * 32768; e += gsz) {
        const int dv = (int)(e & 255), dk = (int)((e >> 8) & 127), dir = (int)((e >> 15) & 1), bh = (int)(e >> 16), b = bh >> 2, h = bh & 3;
        const float v = a.in[dir ? I_SB : I_SF][((((size_t)b * 2 + l) * 4 + h) * 128 + dk) * 256 + dv];
        cx.S0T()[((size_t)bh * 2 + dir) * 32768 + (size_t)dv * 128 + dk] = v;
    }
}

__device__ __forceinline__ void conv_rows(const Args& a, const Ctx& cx, int l, unsigned char* smem) {
    const int tid_ = otid(), lane = tid_ & 63, wave = tid_ >> 6;
    float* wl = (float*)smem;
    {
        const float* wsrc = a.in[I_CWDW] + (size_t)l * 31 * 512;
        for (int e = tid_; e < 31 * 128; e += 512) *(f32x4*)(wl + e * 4) = *(const f32x4*)(wsrc + e * 4);
    }
    __syncthreads();
    for (int rgp = blockIdx.x * 8 + wave; rgp < NTOK / 4; rgp += gridDim.x * 8) {
        const int row0 = rgp * 4;
        int rowbase, T, t0;
        if (row0 < 4096) { rowbase = row0 & ~255; t0 = row0 & 255; T = 256; } else { rowbase = 4096 + ((row0 - 4096) & ~1023); t0 = (row0 - 4096) & 1023; T = 1024; }
        f32x4 c0[4], c1[4];
#pragma unroll
        for (int i = 0; i < 4; ++i) { c0[i] = *(const f32x4*)(a.in[I_CBDW] + l * 512 + lane * 8); c1[i] = *(const f32x4*)(a.in[I_CBDW] + l * 512 + lane * 8 + 4); }
#pragma unroll
        for (int jc = 0; jc < 5; ++jc) {
            u32x4 raw[8]; float vld[8];
#pragma unroll
            for (int jj = 0; jj < 8; ++jj) {
                const int j = jc * 8 + jj;
                if (j < 34) {
                    const int tt = t0 - 15 + j;
                    const int ttc = tt < 0 ? 0 : (tt >= T ? T - 1 : tt);
                    vld[jj] = (tt >= 0 && tt < T) ? 1.0f : 0.0f;
                    raw[jj] = *(const u32x4*)(cx.HGLU() + (size_t)(rowbase + ttc) * 512 + lane * 8);
                }
            }
#pragma unroll
            for (int jj = 0; jj < 8; ++jj) {
                const int j = jc * 8 + jj;
                if (j < 34) {
                    const f32x4 x0 = (f32x4){bflo(raw[jj].x), bfhi(raw[jj].x), bflo(raw[jj].y), bfhi(raw[jj].y)} * vld[jj];
                    const f32x4 x1 = (f32x4){bflo(raw[jj].z), bfhi(raw[jj].z), bflo(raw[jj].w), bfhi(raw[jj].w)} * vld[jj];
#pragma unroll
                    for (int i = 0; i < 4; ++i) {
                        const int tap = j - i;
                        if (tap >= 0 && tap < 31) {
                            c0[i] += x0 * *(const f32x4*)(wl + tap * 512 + lane * 8);
                            c1[i] += x1 * *(const f32x4*)(wl + tap * 512 + lane * 8 + 4);
                        }
                    }
                }
            }
        }
        const float* lg = a.in[I_CLNG] + l * 512 + lane * 8; const float* lb = a.in[I_CLNB] + l * 512 + lane * 8;
        const f32x4 g0 = *(const f32x4*)(lg), g1 = *(const f32x4*)(lg + 4), b0 = *(const f32x4*)(lb), b1 = *(const f32x4*)(lb + 4);
#pragma unroll
        for (int i = 0; i < 4; ++i) {
            f32x4 y0 = c0[i], y1 = c1[i];
            const float mean = wave_sum((y0[0] + y0[1]) + (y0[2] + y0[3]) + (y1[0] + y1[1]) + (y1[2] + y1[3])) * (1.0f / 512.0f);
            y0 = y0 - mean; y1 = y1 - mean;
            const float var = wave_sum((y0[0] * y0[0] + y0[1] * y0[1]) + (y0[2] * y0[2] + y0[3] * y0[3]) + (y1[0] * y1[0] + y1[1] * y1[1]) + (y1[2] * y1[2] + y1[3] * y1[3])) * (1.0f / 512.0f);
            const float rstd = rsqrtf(var + 1e-5f);
            y0 = y0 * rstd * g0 + b0; y1 = y1 * rstd * g1 + b1;
#pragma unroll
            for (int j = 0; j < 4; ++j) { y0[j] = silu(y0[j]); y1[j] = silu(y1[j]); }
            u32x4 w; w.x = cvt_pk_bf16(y0[0], y0[1]); w.y = cvt_pk_bf16(y0[2], y0[3]); w.z = cvt_pk_bf16(y1[0], y1[1]); w.w = cvt_pk_bf16(y1[2], y1[3]);
            *(u32x4*)(cx.BR() + (size_t)(row0 + i) * 2048 + 1024 + lane * 8) = w;
        }
    }
    __syncthreads();
}

__device__ __forceinline__ void ckv_out_rows(const Args& a, const Ctx& cx, int l) {
    const int tid_ = otid(), lane = tid_ & 63, wave = tid_ >> 6;
    const f32x4 g = *(const f32x4*)(a.in[I_KVNORM] + l * 256 + lane * 4);
    for (int row = blockIdx.x * 8 + wave; row < 4096; row += gridDim.x * 8) {
        const f32x4 s0 = *(const f32x4*)(cx.SSQKV() + (size_t)row * 4);
        const float rs = rsqrtf(((s0[0] + s0[1]) + (s0[2] + s0[3])) * (1.0f / 256.0f) + 1e-6f);
        float* o = cx.out + OUT_CKV + ((size_t)((row >> 8) * 2 + l) * 256 + (row & 255)) * 256 + lane * 4;
        *(f32x4*)o = *(const f32x4*)o * rs * g;
    }
}

struct RetUnit { int rowbase, T, h, c, bh; bool ctx; };
__device__ __forceinline__ RetUnit ret_decode(int u) {
    RetUnit r;
    if (u < 128) { r.ctx = true; r.bh = u >> 1; r.h = (u & 7) >> 1; r.c = u & 1; r.rowbase = (u >> 3) * 256; r.T = 256; }
    else { const int v = u - 128; r.ctx = false; r.bh = v >> 3; r.h = (v & 31) >> 3; r.c = v & 7; r.rowbase = 4096 + (v >> 5) * 1024; r.T = 1024; }
    return r;
}
__device__ __forceinline__ float log2_sigmoid(float x) { return -log2f(1.0f + expf(-x)); }

__device__ __forceinline__ void r1_unit(const Args& a, const Ctx& cx, int l, int u, unsigned char* smem) {
    const RetUnit ru = ret_decode(u);
    const int tid_ = otid(), lane = tid_ & 63, wave = tid_ >> 6, lr = lane & 15, lg = lane >> 4;
    const float lgf = log2_sigmoid(a.in[I_RDF][l * 4 + ru.h]), lgb = log2_sigmoid(a.in[I_RDB][l * 4 + ru.h]);
    const size_t T = (size_t)ru.T;
    const bf16_t* vT = cx.VRT() + (size_t)ru.rowbase * 1024 + (size_t)(ru.h * 256) * T + ru.c * 128;
    const bf16_t* kT = cx.KRT() + (size_t)ru.rowbase * 512 + (size_t)(ru.h * 128) * T + ru.c * 128;
    bf16_t* kTs = (bf16_t*)smem;
    bf16_t* vTs = (bf16_t*)(smem + 34816);
    {
        u32x4 kr[4], vr[8];
#pragma unroll
        for (int j = 0; j < 4; ++j) { const int idx = tid_ + 512 * j; kr[j] = *(const u32x4*)(kT + (size_t)(idx >> 4) * T + (idx & 15) * 8); }
#pragma unroll
        for (int j = 0; j < 8; ++j) { const int idx = tid_ + 512 * j; vr[j] = *(const u32x4*)(vT + (size_t)(idx >> 4) * T + (idx & 15) * 8); }
#pragma unroll
        for (int j = 0; j < 4; ++j) { const int idx = tid_ + 512 * j; *(u32x4*)(kTs + (idx >> 4) * 136 + (idx & 15) * 8) = kr[j]; }
#pragma unroll
        for (int j = 0; j < 8; ++j) { const int idx = tid_ + 512 * j; *(u32x4*)(vTs + (idx >> 4) * 136 + (idx & 15) * 8) = vr[j]; }
    }
    __syncthreads();
#pragma unroll 1
    for (int dir = 0; dir < 2; ++dir) {
        const float lgd = dir ? lgb : lgf;
        f32x4 acc[2][8];
#pragma unroll
        for (int mt = 0; mt < 2; ++mt)
#pragma unroll
            for (int nt = 0; nt < 8; ++nt) acc[mt][nt] = (f32x4){0.f, 0.f, 0.f, 0.f};
#pragma unroll
        for (int ks = 0; ks < 4; ++ks) {
            const int j0 = ks * 32 + lg * 8;
            float z[8];
#pragma unroll
            for (int e = 0; e < 8; ++e) z[e] = __builtin_amdgcn_exp2f((float)(dir ? (j0 + e) : 127 - (j0 + e)) * lgd);
            bf16x8 af[2];
#pragma unroll
            for (int mt = 0; mt < 2; ++mt) {
                const u32x4 raw = *(const u32x4*)(vTs + (wave * 32 + mt * 16 + lr) * 136 + j0);
                FragU f;
                f.u.x = cvt_pk_bf16(bflo(raw.x) * z[0], bfhi(raw.x) * z[1]); f.u.y = cvt_pk_bf16(bflo(raw.y) * z[2], bfhi(raw.y) * z[3]);
                f.u.z = cvt_pk_bf16(bflo(raw.z) * z[4], bfhi(raw.z) * z[5]); f.u.w = cvt_pk_bf16(bflo(raw.w) * z[6], bfhi(raw.w) * z[7]);
                af[mt] = f.v;
            }
#pragma unroll
            for (int nt = 0; nt < 8; ++nt) {
                const bf16x8 kf = *(const bf16x8*)(kTs + (nt * 16 + lr) * 136 + j0);
#pragma unroll
                for (int mt = 0; mt < 2; ++mt) acc[mt][nt] = MFMA16(kf, af[mt], acc[mt][nt]);
            }
        }
        float* o = cx.KVT() + ((size_t)u * 2 + dir) * 32768;
        if (ru.ctx) {
#pragma unroll
            for (int mt = 0; mt < 2; ++mt)
#pragma unroll
                for (int nt = 0; nt < 8; ++nt) *(f32x4*)(o + (wave * 32 + mt * 16 + lr) * 128 + nt * 16 + lg * 4) = acc[mt][nt];
        } else {
            bf16_t* ob = (bf16_t*)o;
#pragma unroll
            for (int mt = 0; mt < 2; ++mt)
#pragma unroll
                for (int nt = 0; nt < 8; ++nt) *(u32x2*)(ob + (wave * 32 + mt * 16 + lr) * 128 + nt * 16 + lg * 4) = pack4(acc[mt][nt]);
        }
    }
    __syncthreads();
}

__device__ __forceinline__ void r2_unit(const Args& a, const Ctx& cx, int l, int u, unsigned char* smem) {
    const RetUnit ru = ret_decode(u);
    const int tid = otid(), lane = tid & 63, wave = tid >> 6, lr = lane & 15, lg = lane >> 4;
    const float lgf = log2_sigmoid(a.in[I_RDF][l * 4 + ru.h]), lgb = log2_sigmoid(a.in[I_RDB][l * 4 + ru.h]);
    const size_t T = (size_t)ru.T;
    bf16_t* Sbuf = (bf16_t*)smem;
    bf16_t* Pw = (bf16_t*)(smem + 69632) + wave * (16 * 136);
    const int crow = ru.rowbase + ru.c * 128;
    const int il = wave * 16 + lr;
    bf16x8 qf[4];
#pragma unroll
    for (int ks = 0; ks < 4; ++ks) qf[ks] = ldfrag(cx.QR() + (size_t)(crow + il) * 512 + ru.h * 128 + ks * 32 + lg * 8);
    const bf16_t* vT = cx.VRT() + (size_t)ru.rowbase * 1024 + (size_t)(ru.h * 256) * T + ru.c * 128;
    {
        u32x4 kreg[4];
#pragma unroll
        for (int j = 0; j < 4; ++j) { const int idx = tid + 512 * j; kreg[j] = *(const u32x4*)(cx.KR() + (size_t)(crow + (idx >> 4)) * 512 + ru.h * 128 + (idx & 15) * 8); }
#pragma unroll
        for (int j = 0; j < 4; ++j) { const int idx = tid + 512 * j; *(u32x4*)(Sbuf + (idx >> 4) * 136 + (idx & 15) * 8) = kreg[j]; }
    }
    __syncthreads();
    u32x4 vreg[8];
#pragma unroll
    for (int j = 0; j < 8; ++j) { const int idx = tid + 512 * j; vreg[j] = *(const u32x4*)(vT + (size_t)(idx >> 4) * T + (idx & 15) * 8); }
#pragma unroll
    for (int nt = 0; nt < 8; ++nt) {
        f32x4 sa = (f32x4){0.f, 0.f, 0.f, 0.f};
#pragma unroll
        for (int ks = 0; ks < 4; ++ks) { const bf16x8 kf = *(const bf16x8*)(Sbuf + (nt * 16 + lr) * 136 + ks * 32 + lg * 8); sa = MFMA16(kf, qf[ks], sa); }
        f32x4 p;
#pragma unroll
        for (int rg = 0; rg < 4; ++rg) { const int j = nt * 16 + lg * 4 + rg, d = il - j; p[rg] = sa[rg] * __builtin_amdgcn_exp2f(d >= 0 ? (float)d * lgf : (float)(-d) * lgb); }
        *(u32x2*)(Pw + lr * 136 + nt * 16 + lg * 4) = pack4(p);
    }
    __syncthreads();
#pragma unroll
    for (int j = 0; j < 8; ++j) { const int idx = tid + 512 * j; *(u32x4*)(Sbuf + (idx >> 4) * 136 + (idx & 15) * 8) = vreg[j]; }
    bf16x8 pf[4];
#pragma unroll
    for (int ks = 0; ks < 4; ++ks) pf[ks] = *(const bf16x8*)(Pw + lr * 136 + ks * 32 + lg * 8);
    __syncthreads();
    f32x4 oacc[16];
#pragma unroll
    for (int nt2 = 0; nt2 < 16; ++nt2) {
        f32x4 o = (f32x4){0.f, 0.f, 0.f, 0.f};
#pragma unroll
        for (int ks = 0; ks < 4; ++ks) { const bf16x8 vf = *(const bf16x8*)(Sbuf + (nt2 * 16 + lr) * 136 + ks * 32 + lg * 8); o = MFMA16(vf, pf[ks], o); }
        oacc[nt2] = o;
    }
    const int nc = ru.ctx ? 2 : 8;
    for (int dir = 0; dir < 2; ++dir) {
        const bool have = ru.ctx ? (dir == 0 ? ru.c == 1 : ru.c == 0) : true;
        if (!have) continue;
        const float lgd = dir ? lgb : lgf;
        __syncthreads();
        {
            int nterm;
            if (ru.ctx) nterm = 1; else nterm = dir == 0 ? ru.c + 1 : nc - ru.c;
#pragma unroll 1
            for (int hf = 0; hf < 2; ++hf) {
                f32x4 sacc[8];
#pragma unroll
                for (int it = 0; it < 8; ++it) sacc[it] = (f32x4){0.f, 0.f, 0.f, 0.f};
                if (ru.ctx) {
                    const float* p = cx.KVT() + ((size_t)(dir == 0 ? u - 1 : u + 1) * 2 + dir) * 32768;
#pragma unroll
                    for (int it = 0; it < 8; ++it) sacc[it] = *(const f32x4*)(p + (size_t)((hf * 8 + it) * 512 + tid) * 4);
                } else {
                    {
                        const float* p = cx.S0T() + ((size_t)ru.bh * 2 + dir) * 32768;
                        const float w = exp2f((float)((dir == 0 ? ru.c : nc - 1 - ru.c) * 128) * lgd);
#pragma unroll
                        for (int it = 0; it < 8; ++it) sacc[it] = *(const f32x4*)(p + (size_t)((hf * 8 + it) * 512 + tid) * 4) * w;
                    }
                    for (int m = 1; m < nterm; m += 4) {
                        const bf16_t* p[4]; float w[4];
#pragma unroll
                        for (int q = 0; q < 4; ++q) {
                            const int mm = (m + q < nterm) ? m + q : m;
                            if (dir == 0) { p[q] = (const bf16_t*)(cx.KVT() + ((size_t)(u - ru.c + (mm - 1)) * 2 + 0) * 32768); w[q] = exp2f((float)((ru.c - mm) * 128) * lgd); }
                            else { p[q] = (const bf16_t*)(cx.KVT() + ((size_t)(u + mm) * 2 + 1) * 32768); w[q] = exp2f((float)((mm - 1) * 128) * lgd); }
                            if (m + q >= nterm) w[q] = 0.f;
                        }
                        u32x2 ldq[4][8];
#pragma unroll
                        for (int q = 0; q < 4; ++q)
#pragma unroll
                            for (int it = 0; it < 8; ++it) ldq[q][it] = *(const u32x2*)(p[q] + (size_t)((hf * 8 + it) * 512 + tid) * 4);
#pragma unroll
                        for (int q = 0; q < 4; ++q)
#pragma unroll
                            for (int it = 0; it < 8; ++it) sacc[it] += unpack4(ldq[q][it]) * w[q];
                    }
                }
#pragma unroll
                for (int it = 0; it < 8; ++it) { const int e4 = (hf * 8 + it) * 512 + tid; *(u32x2*)(Sbuf + (e4 >> 5) * 136 + (e4 & 31) * 4) = pack4(sacc[it]); }
            }
        }
        __syncthreads();
        const float xi = dir == 0 ? exp2f((float)(il + 1) * lgf) : exp2f((float)(128 - il) * lgb);
#pragma unroll
        for (int nt2 = 0; nt2 < 16; ++nt2) {
            f32x4 cacc = (f32x4){0.f, 0.f, 0.f, 0.f};
#pragma unroll
            for (int ks = 0; ks < 4; ++ks) { const bf16x8 sf = *(const bf16x8*)(Sbuf + (nt2 * 16 + lr) * 136 + ks * 32 + lg * 8); cacc = MFMA16(sf, qf[ks], cacc); }
            oacc[nt2] += cacc * xi;
        }
    }
    float sum = 0.f;
#pragma unroll
    for (int nt2 = 0; nt2 < 16; ++nt2) sum += (oacc[nt2][0] + oacc[nt2][1]) + (oacc[nt2][2] + oacc[nt2][3]);
    sum += __shfl_xor(sum, 16); sum += __shfl_xor(sum, 32);
    const float mean = sum * (1.0f / 256.0f);
    float sq = 0.f;
#pragma unroll
    for (int nt2 = 0; nt2 < 16; ++nt2) { oacc[nt2] = oacc[nt2] - mean; sq += (oacc[nt2][0] * oacc[nt2][0] + oacc[nt2][1] * oacc[nt2][1]) + (oacc[nt2][2] * oacc[nt2][2] + oacc[nt2][3] * oacc[nt2][3]); }
    sq += __shfl_xor(sq, 16); sq += __shfl_xor(sq, 32);
    const float rstd = rsqrtf(sq * (1.0f / 256.0f) + 1e-5f);
    const size_t row = (size_t)(crow + il);
    u32x2 gts[16];
#pragma unroll
    for (int nt2 = 0; nt2 < 16; ++nt2) gts[nt2] = *(const u32x2*)(cx.GR() + row * 1024 + ru.h * 256 + nt2 * 16 + lg * 4);
#pragma unroll
    for (int nt2 = 0; nt2 < 16; ++nt2) {
        const int col = ru.h * 256 + nt2 * 16 + lg * 4;
        *(u32x2*)(cx.BR() + row * 2048 + col) = pack4(oacc[nt2] * rstd * unpack4(gts[nt2]));
    }
    if (ru.ctx) {
        const int c = ru.c, s = u >> 3;
        float* o = cx.out + (c == 0 ? OUT_RF : OUT_RB) + ((size_t)(s * 2 + l) * 4 + ru.h) * 32768;
        const float* A = cx.KVT() + ((size_t)u * 2 + c) * 32768;
        const float* B = cx.KVT() + ((size_t)(c == 0 ? u + 1 : u - 1) * 2 + c) * 32768;
        const float w = exp2f(128.0f * (c == 0 ? lgf : lgb));
        float* Tt = (float*)smem;
#pragma unroll 1
        for (int q4 = 0; q4 < 4; ++q4) {
            __syncthreads();
            f32x4 va[4], vb[4];
#pragma unroll
            for (int j = 0; j < 4; ++j) { const int idx = tid + 512 * j, dvl = idx >> 5, dk4 = (idx & 31) * 4; va[j] = *(const f32x4*)(A + (q4 * 64 + dvl) * 128 + dk4); vb[j] = *(const f32x4*)(B + (q4 * 64 + dvl) * 128 + dk4); }
#pragma unroll
            for (int j = 0; j < 4; ++j) { const int idx = tid + 512 * j, dvl = idx >> 5, dk4 = (idx & 31) * 4; const f32x4 r = va[j] * w + vb[j];
                Tt[dvl * 129 + dk4] = r[0]; Tt[dvl * 129 + dk4 + 1] = r[1]; Tt[dvl * 129 + dk4 + 2] = r[2]; Tt[dvl * 129 + dk4 + 3] = r[3]; }
            __syncthreads();
#pragma unroll
            for (int j = 0; j < 4; ++j) { const int idx = tid + 512 * j, dk = idx >> 4, dq = (idx & 15) * 4;
                const f32x4 r = (f32x4){Tt[dq * 129 + dk], Tt[(dq + 1) * 129 + dk], Tt[(dq + 2) * 129 + dk], Tt[(dq + 3) * 129 + dk]};
                *(f32x4*)(o + dk * 256 + q4 * 64 + dq) = r; }
        }
    }
    __syncthreads();
}

__device__ __forceinline__ void attn_unit(const Ctx& cx, int uidx, unsigned char* smem) {
    const int tid = otid(), lane = tid & 63, wave = tid >> 6, lr = lane & 15, lg = lane >> 4;
    int qrow0, head, kbase, Tk;
    if (uidx < 256) { const int b = uidx >> 6; head = (uidx & 63) >> 3; qrow0 = 4096 + b * 1024 + (uidx & 7) * 128; kbase = 4096 + 1280 * b; Tk = 1280; }
    else { const int v = uidx - 256, b = v >> 4; head = (v & 15) >> 1; qrow0 = b * 256 + (v & 1) * 128; kbase = b * 256; Tk = 256; }
    constexpr int BUFB = 23552, KR_OFF = 9216, VT_OFF = 14336;
    bf16_t* Pw = (bf16_t*)(smem + 2 * BUFB) + wave * (16 * 72);
    const size_t row = (size_t)(qrow0 + wave * 16 + lr);
    bf16x8 qf[3];
#pragma unroll
    for (int ks = 0; ks < 3; ++ks) qf[ks] = ldfrag(cx.Q() + row * 768 + head * 96 + ks * 32 + lg * 8);
    const int r8 = tid >> 3, s8 = tid & 7, r4 = (tid >> 2) & 63, s4 = tid & 3;
    const bf16_t* gk = cx.KN() + (size_t)(kbase + r8) * 512 + head * 64 + s8 * 8;
    const bf16_t* gv = cx.VT() + (size_t)kbase * 512 + (size_t)(head * 64 + r8) * Tk + s8 * 8;
    const bf16_t* gr = cx.KROPE() + (size_t)(kbase + r4) * 32 + s4 * 8;
    const int lk = r8 * 72 + s8 * 8, lrp = r4 * 40 + s4 * 8;
    const int nkb = Tk / 64;
    u32x4 pk = *(const u32x4*)gk, pv = *(const u32x4*)gv, pr = *(const u32x4*)gr;
    {
        bf16_t* b0 = (bf16_t*)smem;
        *(u32x4*)(b0 + lk) = pk; *(u32x4*)(b0 + VT_OFF / 2 + lk) = pv; if (tid < 256) *(u32x4*)(b0 + KR_OFF / 2 + lrp) = pr;
    }
    __syncthreads();
    float m_run = -1e30f, l_part = 0.f;
    f32x4 oacc[4];
#pragma unroll
    for (int i = 0; i < 4; ++i) oacc[i] = (f32x4){0.f, 0.f, 0.f, 0.f};
    for (int kb = 0; kb < nkb; ++kb) {
        const bool more = kb + 1 < nkb;
        if (more) { const size_t k1 = (size_t)(kb + 1) * 64; pk = *(const u32x4*)(gk + k1 * 512); pv = *(const u32x4*)(gv + k1); pr = *(const u32x4*)(gr + k1 * 32); }
        const bf16_t* cb = (const bf16_t*)(smem + (kb & 1) * BUFB);
        f32x4 s[4];
#pragma unroll
        for (int nt = 0; nt < 4; ++nt) {
            const bf16x8 k0 = *(const bf16x8*)(cb + (nt * 16 + lr) * 72 + lg * 8), k1 = *(const bf16x8*)(cb + (nt * 16 + lr) * 72 + 32 + lg * 8),
                         k2 = *(const bf16x8*)(cb + KR_OFF / 2 + (nt * 16 + lr) * 40 + lg * 8);
            f32x4 z = (f32x4){0.f, 0.f, 0.f, 0.f};
            z = MFMA16(k0, qf[0], z); z = MFMA16(k1, qf[1], z); z = MFMA16(k2, qf[2], z);
            s[nt] = z;
        }
        float mx = -1e30f;
#pragma unroll
        for (int nt = 0; nt < 4; ++nt) mx = fmaxf(mx, fmaxf(fmaxf(s[nt][0], s[nt][1]), fmaxf(s[nt][2], s[nt][3])));
        mx = fmaxf(mx, __shfl_xor(mx, 16)); mx = fmaxf(mx, __shfl_xor(mx, 32));
        const float m_new = fmaxf(m_run, mx), alpha = __builtin_amdgcn_exp2f(m_run - m_new);
        m_run = m_new;
        float ps = 0.f;
#pragma unroll
        for (int nt = 0; nt < 4; ++nt) {
#pragma unroll
            for (int rg = 0; rg < 4; ++rg) { s[nt][rg] = __builtin_amdgcn_exp2f(s[nt][rg] - m_new); ps += s[nt][rg]; }
            *(u32x2*)(Pw + lr * 72 + nt * 16 + lg * 4) = pack4(s[nt]);
        }
        l_part = l_part * alpha + ps;
#pragma unroll
        for (int i = 0; i < 4; ++i) oacc[i] = oacc[i] * alpha;
        bf16x8 pf[2];
#pragma unroll
        for (int ks = 0; ks < 2; ++ks) pf[ks] = *(const bf16x8*)(Pw + lr * 72 + ks * 32 + lg * 8);
#pragma unroll
        for (int nt2 = 0; nt2 < 4; ++nt2)
#pragma unroll
            for (int ks = 0; ks < 2; ++ks) { const bf16x8 vf = *(const bf16x8*)(cb + VT_OFF / 2 + (nt2 * 16 + lr) * 72 + ks * 32 + lg * 8); oacc[nt2] = MFMA16(vf, pf[ks], oacc[nt2]); }
        if (more) {
            bf16_t* nb = (bf16_t*)(smem + ((kb + 1) & 1) * BUFB);
            *(u32x4*)(nb + lk) = pk; *(u32x4*)(nb + VT_OFF / 2 + lk) = pv; if (tid < 256) *(u32x4*)(nb + KR_OFF / 2 + lrp) = pr;
        }
        __syncthreads();
    }
    float lt = l_part + __shfl_xor(l_part, 16); lt += __shfl_xor(lt, 32);
    const float inv = 1.0f / lt;
#pragma unroll
    for (int nt2 = 0; nt2 < 4; ++nt2) *(u32x2*)(cx.BR() + row * 2048 + 1536 + head * 64 + nt2 * 16 + lg * 4) = pack4(oacc[nt2] * inv);
}

__device__ __forceinline__ void grid_barrier(unsigned* cnt, unsigned target) {
    asm volatile("s_waitcnt vmcnt(0) lgkmcnt(0)" ::: "memory");
    __syncthreads();
    if (threadIdx.x == 0) {
        __builtin_amdgcn_fence(__ATOMIC_RELEASE, "agent");
        asm volatile("s_waitcnt vmcnt(0)" ::: "memory");
        __hip_atomic_fetch_add(cnt, 1u, __ATOMIC_RELAXED, __HIP_MEMORY_SCOPE_AGENT);
        while (__hip_atomic_load(cnt, __ATOMIC_RELAXED, __HIP_MEMORY_SCOPE_AGENT) < target) __builtin_amdgcn_s_sleep(1);
        __builtin_amdgcn_fence(__ATOMIC_ACQUIRE, "agent");
        asm volatile("s_waitcnt vmcnt(0)" ::: "memory");
    }
    __syncthreads();
}

#define XB_XCNT(j)  (256  + 64 * (j))
#define XB_XSUB(j)  (1280 + 64 * (j))
#define XB_XGEN(j)  (2304 + 64 * (j))
#define XB_TOP      3328
#define XB_TOPGEN   3392
__device__ __forceinline__ unsigned xb_ld(unsigned* p)              { return __hip_atomic_load(p, __ATOMIC_RELAXED, __HIP_MEMORY_SCOPE_AGENT); }
__device__ __forceinline__ unsigned xb_add(unsigned* p, unsigned v) { return __hip_atomic_fetch_add(p, v, __ATOMIC_RELAXED, __HIP_MEMORY_SCOPE_AGENT); }
__device__ __forceinline__ unsigned xb_xcc_id() { return (unsigned)__builtin_amdgcn_s_getreg((3 << 11) | 20) & 0xFu; }
__device__ __forceinline__ void xcd_barrier(unsigned* bar, volatile unsigned* st) {
    asm volatile("s_waitcnt vmcnt(0) lgkmcnt(0)" ::: "memory");
    __syncthreads();
    if (threadIdx.x == 0) {
        const unsigned x = xb_xcc_id();
        unsigned nloc = st[0], nx = st[1];
        if (nloc == 0u) {
            unsigned cntx = 0u, mine = 0u;
#pragma unroll
            for (unsigned j = 0; j < 16; ++j) { const unsigned c = xb_ld(&bar[XB_XCNT(j)]); cntx += (c > 0u) ? 1u : 0u; mine = (j == x) ? c : mine; }
            nloc = mine > 0u ? mine : 1u; nx = cntx > 0u ? cntx : 1u; st[0] = nloc; st[1] = nx;
        }
        const unsigned old = xb_add(&bar[XB_XSUB(x)], 1u);
        const unsigned gen = old / nloc;
        if (old + 1u == (gen + 1u) * nloc) {
            __builtin_amdgcn_fence(__ATOMIC_RELEASE, "agent");
            asm volatile("s_waitcnt vmcnt(0)" ::: "memory");
            const unsigned og = xb_add(&bar[XB_TOP], 1u);
            const unsigned tg = og / nx;
            if (og + 1u == (tg + 1u) * nx) xb_add(&bar[XB_TOPGEN], 1u);
            else while (xb_ld(&bar[XB_TOPGEN]) == tg) __builtin_amdgcn_s_sleep(1);
            __builtin_amdgcn_fence(__ATOMIC_ACQUIRE, "agent");
            xb_add(&bar[XB_XGEN(x)], 1u);
            asm volatile("s_waitcnt vmcnt(0)" ::: "memory");
        } else {
            while (xb_ld(&bar[XB_XGEN(x)]) == gen) __builtin_amdgcn_s_sleep(1);
            __builtin_amdgcn_fence(__ATOMIC_ACQUIRE, "agent");
            asm volatile("s_waitcnt vmcnt(0)" ::: "memory");
        }
    }
    __syncthreads();
}

__global__ void __launch_bounds__(512) mk_fwd(Args a) {
    extern __shared__ __attribute__((aligned(16))) unsigned char smem[];
    Ctx cx;
    cx.ws = a.ws; cx.out = a.out;
    LAS unsigned char* lds = (LAS unsigned char*)smem;
    const int G = gridDim.x;
    unsigned* const gbar = (unsigned*)(a.ws + WS_BAR);
    unsigned bar_round = 0;
    if (a.ph_hi > 1000) cg::this_grid().sync();
    volatile unsigned* const bst = (volatile unsigned*)(smem + STAGE_BYTES);
    if (threadIdx.x == 0) { bst[0] = 0u; bst[1] = 0u; (void)xb_add(&gbar[XB_XCNT(xb_xcc_id())], 1u); }
    __syncthreads();
#define GRID_SYNC() do { ++bar_round; if (bar_round == 1u) grid_barrier(gbar, (unsigned)G); else xcd_barrier(gbar, bst); } while (0)

    for (int ph = a.ph_lo; ph < a.ph_hi; ++ph) {
        cx.ws = a.ws; cx.out = a.out; asm volatile("" : "+s"(cx.ws), "+s"(cx.out));
        int l = 0, k = -1;
        if (ph >= 2) { l = (ph - 2) / 12; k = (ph - 2) % 12; }
        const int nrep = 1 + ((MK_REPEAT_MASK >> (ph == 0 ? 12 : (ph == 1 ? 13 : k))) & 1);
        for (int rep = 0; rep < nrep; ++rep) {
        bool do_gemm = false; GemmCall g; g.A = nullptr; g.Bt = nullptr; g.ld2 = 0; g.gt = 0;
        if (ph == 0) {
            if (G == 256) {
                const int c = blockIdx.x;
                if (c < 224) for (int t = c; t < 1792; t += 224) prep_tile(a, 0, t, smem);
                else for (int t = 1792 + (c - 224); t < PREP_TILES; t += 32) prep_tile(a, 0, t, smem);
            } else {
                for (int t = blockIdx.x; t < PREP_TILES; t += G) prep_tile(a, 0, t, smem);
            }
            ada_phase(a, cx, smem);
        } else if (ph == 1) {
            ln_phase(a, cx, 0, -1);
        } else {
            switch (k) {
            case 0: do_gemm = true; g.A = (const char*)cx.H(); g.Bt = (const char*)(a.ws + W_FFN1_IN); g.ld2 = 2048; g.gt = GT_FFN_IN; break;
            case 1: do_gemm = true; g.A = (const char*)cx.ACT(); g.Bt = (const char*)(a.ws + W_FFN1_OUT); g.ld2 = 5632; g.gt = GT_FFN_OUT; break;
            case 2: ln_phase(a, cx, l, 0); break;
            case 3: cache_prep(a, cx, l); do_gemm = true; g.A = (const char*)cx.H(); g.Bt = (const char*)(a.ws + W_MIX_IN); g.ld2 = 2048; g.gt = GT_MIX_IN; break;
            case 4:
                conv_rows(a, cx, l, smem);
                ckv_out_rows(a, cx, l);
                for (int u = blockIdx.x; u < 256; u += G) r1_unit(a, cx, l, u, smem);
                do_gemm = true; g.A = (const char*)cx.MQKV(); g.Bt = (const char*)(a.ws + W_M2); g.ld2 = 1536; g.gt = GT_M2;
                if (G >= 240) {
                    Unit u0; const int t = otid();
                    if (sched_next(g, 0, blockIdx.x, G, u0) && t < 256) {
                        const int r = u0.pm * 256 + t; float rs = 1.0f;
                        if (u0.kind == EK_QUP) { const f32x4 s0 = *(const f32x4*)(cx.SSQQ() + (size_t)r * 8), s1 = *(const f32x4*)(cx.SSQQ() + (size_t)r * 8 + 4);
                            rs = rsqrtf((((s0[0] + s0[1]) + (s0[2] + s0[3])) + ((s1[0] + s1[1]) + (s1[2] + s1[3]))) * (1.0f / 512.0f) + 1e-6f) * QSCALE; }
                        else if (u0.kind == EK_KVUP) { const f32x4 s0 = *(const f32x4*)(cx.SSQKV() + (size_t)r * 4); rs = rsqrtf(((s0[0] + s0[1]) + (s0[2] + s0[3])) * (1.0f / 256.0f) + 1e-6f); }
                        *(float*)(smem + RS_OFF + 4 * t) = rs;
                    }
                }
                __syncthreads();
                g.A = (const char*)cx.MQKV(); g.Bt = (const char*)(a.ws + W_M2); g.ld2 = 1536; g.gt = GT_M2; break;
            case 5:
                for (int u = blockIdx.x; u < 256; u += G) r2_unit(a, cx, l, u, smem);
                for (int u = blockIdx.x; u < 512; u += G) attn_unit(cx, u, smem);
                break;
            case 6: do_gemm = true; g.A = (const char*)cx.BR(); g.Bt = (const char*)(a.ws + W_BR); g.ld2 = 4096; g.gt = GT_BR; break;
            case 7: do_gemm = true; g.A = (const char*)cx.MG(); g.Bt = (const char*)(a.ws + W_O2); g.ld2 = 4096; g.gt = GT_MIX_O; break;
            case 8: ln_phase(a, cx, l, 1); break;
            case 9: do_gemm = true; g.A = (const char*)cx.H(); g.Bt = (const char*)(a.ws + W_FFN2_IN); g.ld2 = 2048; g.gt = GT_FFN_IN; break;
            case 10: do_gemm = true; g.A = (const char*)cx.ACT(); g.Bt = (const char*)(a.ws + W_FFN2_OUT); g.ld2 = 5632; g.gt = GT_FFN_OUT; break;
            default:
                ln_phase(a, cx, l, 2);
                if (l == 0) for (int t = blockIdx.x; t < PREP_TILES; t += G) prep_tile(a, 1, t, smem);
                break;
            }
        }
        if (do_gemm) gemm_phase(lds, g, cx, a, l);
        if (rep + 1 < nrep) GRID_SYNC();
        }
        if (ph + 1 < a.ph_hi) GRID_SYNC();
        if ((MK_REPEAT_MASK >> 14) & 1) { if (ph == 5) for (int q = 0; q < 20; ++q) GRID_SYNC(); }
    }
}

constexpr int LDS_BYTES = STAGE_BYTES + 16 + 1024;

extern "C" void kernel_launch(void* const* d_in, const int* in_sizes, int n_in, void* d_out, int out_size, void* d_ws, size_t ws_size, hipStream_t stream) {
    static int grid = 0;
    if (grid == 0) {
        if (n_in != 31 || ws_size < WS_END) { fprintf(stderr, "kernel_launch: unexpected n_in %d or ws_size %zu (< %zu)\n", n_in, ws_size, (size_t)WS_END); grid = -1; return; }
        int dev = 0, cus = 0, per_cu = 0;
        hipGetDevice(&dev);
        hipDeviceGetAttribute(&cus, hipDeviceAttributeMultiprocessorCount, dev);
        if (hipFuncSetAttribute((const void*)mk_fwd, hipFuncAttributeMaxDynamicSharedMemorySize, LDS_BYTES) != hipSuccess) { fprintf(stderr, "kernel_launch: hipFuncSetAttribute failed\n"); grid = -1; return; }
        hipOccupancyMaxActiveBlocksPerMultiprocessor(&per_cu, (const void*)mk_fwd, 512, LDS_BYTES);
        (void)hipGetLastError();
        if (per_cu < 1 || cus < 1) { fprintf(stderr, "kernel_launch: per_cu %d cus %d\n", per_cu, cus); grid = -1; return; }
        grid = cus;
    }
    if (grid < 0) return;
    Args a{};
    for (int i = 0; i < 31; ++i) a.in[i] = (const float*)d_in[i];
    a.out = (float*)d_out; a.ws = (unsigned char*)d_ws;
#if MK_PER_PHASE
    for (int ph = 0; ph < MK_PH_HI; ++ph) {
        a.ph_lo = ph; a.ph_hi = ph + MK_DBG_SPAN;
        hipLaunchKernelGGL(mk_fwd, dim3(grid), dim3(512), LDS_BYTES, stream, a);
    }
#else
    a.ph_lo = 0; a.ph_hi = MK_PH_HI;
    (void)hipMemsetAsync((unsigned char*)d_ws + WS_BAR, 0, 16384, stream);
    void* args[] = {&a};
    hipError_t e = hipLaunchCooperativeKernel((const void*)mk_fwd, dim3(grid), dim3(512), args, LDS_BYTES, stream);
    if (e != hipSuccess) fprintf(stderr, "kernel_launch: cooperative launch failed: %s\n", hipGetErrorString(e));
#endif
}
```

```cpp
#include <hip/hip_runtime.h>
#include <hip/hip_cooperative_groups.h>
#include <cstdio>
namespace cg = cooperative_groups;

#ifndef MK_PER_PHASE
#define MK_PER_PHASE 0
#endif
#ifndef MK_DBG_SPAN
#define MK_DBG_SPAN 1
#endif
#ifndef MK_REPEAT_MASK
#define MK_REPEAT_MASK 0
#endif
#ifndef MK_PH_HI
#define MK_PH_HI 26
#endif

#define LAS __attribute__((address_space(3)))
typedef unsigned short bf16_t;
typedef short bf16x8 __attribute__((ext_vector_type(8)));
typedef float f32x4 __attribute__((ext_vector_type(4)));
typedef unsigned u32x4 __attribute__((ext_vector_type(4)));
typedef unsigned u32x2 __attribute__((ext_vector_type(2)));

constexpr int NTOK = 8192;
constexpr float ALPHA = 1.41421356237f;
constexpr float QSCALE = 0.10206207261f * 1.44269504089f;
constexpr int N_PHASES = 26;

constexpr size_t OUT_CKV = 8388608, OUT_KROPE = 10485760, OUT_RF = 10747904, OUT_RB = 14942208;

constexpr size_t MBy = 1u << 20;
constexpr size_t W_FFN1_IN = 0, W_FFN1_OUT = 11534336, W_FFN2_IN = 17301504, W_FFN2_OUT = 28835840, W_MIX_IN = 34603008,
                 W_M2 = 51380224, W_BR = 55705600, W_O2 = 59899904;
constexpr size_t WS_MOD = 62 * MBy, WS_SSQQ = 62 * MBy + 512 * 1024, WS_SSQKV = 62 * MBy + 768 * 1024;
constexpr size_t WS_BAR = 62 * MBy + 960 * 1024;
constexpr size_t WS_Z1 = 63 * MBy, WS_ACT = WS_Z1, WS_H = WS_Z1 + 48 * MBy, WS_KVT = WS_Z1;
constexpr size_t WS_Z2 = 127 * MBy, WS_F = WS_Z2, WS_BR = WS_Z2, WS_SCR = WS_Z2 + 32 * MBy, WS_Q = WS_Z2 + 32 * MBy,
                 WS_KN = WS_Z2 + 45 * MBy, WS_VT = WS_Z2 + 54 * MBy, WS_KROPE = WS_Z2 + 63 * MBy;
constexpr size_t WS_Z3 = 191 * MBy, WS_HGLU = WS_Z3, WS_QR = WS_Z3 + 8 * MBy, WS_KR = WS_Z3 + 16 * MBy, WS_KRT = WS_Z3 + 24 * MBy,
                 WS_VRT = WS_Z3 + 32 * MBy, WS_GR = WS_Z3 + 48 * MBy, WS_MQKV = WS_Z3 + 64 * MBy, WS_MG = WS_Z3;
constexpr size_t WS_BG = 269 * MBy, WS_S0T = 317 * MBy, WS_END = 321 * MBy;

struct Args {
    const float* in[31];
    float* out;
    unsigned char* ws;
    int ph_lo, ph_hi;
};
enum { I_XP = 0, I_XS, I_CKV, I_CKR, I_SF, I_SB, I_C, I_CCTX, I_ADAW, I_ADAB, I_F1IN, I_F1OUT, I_F2IN, I_F2OUT, I_LNG, I_LNB, I_MIXIN,
       I_CWDW, I_CBDW, I_CLNG, I_CLNB, I_CWOUT, I_RDF, I_RDB, I_RWOUT, I_QNORM, I_WUQ, I_KVNORM, I_WUKV, I_MWOUT, I_WO };

typedef float f32x2_t __attribute__((ext_vector_type(2)));
typedef __bf16 bf16x2_t __attribute__((ext_vector_type(2)));
__device__ __forceinline__ unsigned cvt_pk_bf16(float lo, float hi) { const f32x2_t v = {lo, hi}; return __builtin_bit_cast(unsigned, __builtin_convertvector(v, bf16x2_t)); }
__device__ __forceinline__ bf16_t f2bf(float x) { return (bf16_t)(cvt_pk_bf16(x, 0.f) & 0xffffu); }
__device__ __forceinline__ float bflo(unsigned w) { return __uint_as_float(w << 16); }
__device__ __forceinline__ float bfhi(unsigned w) { return __uint_as_float(w & 0xffff0000u); }
__device__ __forceinline__ float sigm(float x) { return __builtin_amdgcn_rcpf(1.0f + __expf(-x)); }
__device__ __forceinline__ float silu(float x) { return x * sigm(x); }
__device__ __forceinline__ float wave_sum(float v) {
#pragma unroll
    for (int o = 32; o >= 1; o >>= 1) v += __shfl_xor(v, o);
    return v;
}
__device__ __forceinline__ u32x2 pack4(f32x4 v) { u32x2 w; w.x = cvt_pk_bf16(v[0], v[1]); w.y = cvt_pk_bf16(v[2], v[3]); return w; }
__device__ __forceinline__ f32x4 unpack4(u32x2 w) { return (f32x4){bflo(w.x), bfhi(w.x), bflo(w.y), bfhi(w.y)}; }
union FragU { u32x4 u; bf16x8 v; };
__device__ __forceinline__ u32x4 pack8(f32x4 a, f32x4 b) { u32x4 w; w.x = cvt_pk_bf16(a[0], a[1]); w.y = cvt_pk_bf16(a[2], a[3]); w.z = cvt_pk_bf16(b[0], b[1]); w.w = cvt_pk_bf16(b[2], b[3]); return w; }
__device__ __forceinline__ int perm32(int rho) { const int n = rho >> 4, i = rho & 15; return 8 * (i >> 2) + 4 * n + (i & 3); }
__device__ __forceinline__ bf16x8 ldfrag(const bf16_t* p) { return *(const bf16x8*)p; }
#define MFMA16(a, b, c) __builtin_amdgcn_mfma_f32_16x16x32_bf16((a), (b), (c), 0, 0, 0)

__device__ __forceinline__ int otid() { int t = threadIdx.x; asm volatile("" : "+v"(t)); return t; }
struct Ctx {
    unsigned char* ws; float* out;
#define CXP(name, type, off) __device__ __forceinline__ type* name() const { return (type*)(ws + (off)); }
    CXP(MOD, float, WS_MOD) CXP(SSQQ, float, WS_SSQQ) CXP(SSQKV, float, WS_SSQKV) CXP(ACT, bf16_t, WS_ACT) CXP(H, bf16_t, WS_H) CXP(KVT, float, WS_KVT)
    CXP(F, float, WS_F) CXP(BR, bf16_t, WS_BR) CXP(SCR, float, WS_SCR) CXP(Q, bf16_t, WS_Q) CXP(HGLU, bf16_t, WS_HGLU) CXP(QR, bf16_t, WS_QR)
    CXP(KR, bf16_t, WS_KR) CXP(KRT, bf16_t, WS_KRT) CXP(VRT, bf16_t, WS_VRT) CXP(GR, bf16_t, WS_GR) CXP(MQKV, bf16_t, WS_MQKV) CXP(MG, bf16_t, WS_MG)
    CXP(BG, bf16_t, WS_BG) CXP(KN, bf16_t, WS_KN) CXP(VT, bf16_t, WS_VT) CXP(KROPE, bf16_t, WS_KROPE) CXP(S0T, float, WS_S0T)
#undef CXP
};

constexpr int BM = 256, BK = 64, HALF = 128, HTB = HALF * BK * 2, STAGE_BYTES = 8 * HTB;
constexpr int RS_OFF = STAGE_BYTES + 16;
__device__ __forceinline__ int lds_byte(int r, int c) { const int st = (r >> 4) * 2 + (c >> 5), rr = r & 15, cc = c & 31, ob = rr * 64 + cc * 2; return st * 1024 + (ob ^ (((ob >> 9) & 1) << 5)); }
__device__ __forceinline__ void stage_rc(int b, int& R, int& C) { const int st = b / 1024, sb = b % 1024, swz = sb ^ (((sb >> 9) & 1) << 5); R = (st >> 1) * 16 + swz / 64; C = (st & 1) * 32 + (swz % 64) / 2; }

enum { GT_FFN_IN = 0, GT_FFN_OUT, GT_MIX_IN, GT_M2, GT_BR, GT_MIX_O };
enum { EK_SWIGLU = 0, EK_F32, EK_MIXIN, EK_QUP, EK_KVUP, EK_KVC, EK_BR0, EK_BR1, EK_BR2 };
struct Unit { size_t aoff, boff; int nt, kind, pm, pn, kz; };
struct GemmCall { const char* A; const char* Bt; unsigned ld2; int gt; };

__device__ __forceinline__ void tile_order(int L, int nM, int nN, int& pm, int& pn) {
    const int nwg = nM * nN; int wgid = L;
    { const int q = nwg / 8, r = nwg % 8, xcd = wgid % 8, off = wgid / 8; wgid = (xcd < r ? xcd * (q + 1) : r * (q + 1) + (xcd - r) * q) + off; }
    const int nig = 8 * nN, gid = wgid / nig, fm = gid * 8, gsz = (nM - fm) < 8 ? (nM - fm) : 8;
    pm = fm + ((wgid % nig) % gsz); pn = (wgid % nig) / gsz;
}

__device__ __forceinline__ bool sched_next(const GemmCall& g, int i, int c, int G, Unit& u) {
    const int L = i * G + c;
    u.kz = 0;
    switch (g.gt) {
    case GT_FFN_IN: {
        if (L >= 32 * 22) return false;
        int pm, pn; tile_order(L, 32, 22, pm, pn);
        u.pm = pm; u.pn = pn; u.nt = 16; u.kind = EK_SWIGLU; u.aoff = (size_t)pm * 256 * g.ld2; u.boff = (size_t)pn * 256 * g.ld2; return true; }
    case GT_FFN_OUT: {
        if (L >= 256) return false;
        int pm, pe; tile_order(L, 32, 8, pm, pe);
        u.pm = pm; u.pn = pe >> 1; u.kz = pe & 1; u.nt = 22; u.kind = EK_F32;
        u.aoff = (size_t)pm * 256 * g.ld2 + (size_t)u.kz * 1408 * 2; u.boff = (size_t)u.pn * 256 * g.ld2 + (size_t)u.kz * 1408 * 2; return true; }
    case GT_MIX_IN: {
        if (L >= 1024) return false;
        int pm, pn; tile_order(L, 32, 32, pm, pn);
        u.pm = pm; u.pn = pn; u.nt = 16; u.kind = EK_MIXIN; u.aoff = (size_t)pm * 256 * g.ld2; u.boff = (size_t)pn * 256 * g.ld2; return true; }
    case GT_M2: {
        if (L >= 240) return false;
        if (L < 96) { u.pm = L & 31; u.pn = L >> 5; u.nt = 8; u.kind = EK_QUP; u.aoff = (size_t)u.pm * 256 * g.ld2; u.boff = (size_t)u.pn * 256 * g.ld2; }
        else if (L < 224) { const int t = L - 96; u.pm = t & 31; u.pn = t >> 5; u.nt = 4; u.kind = EK_KVUP; u.aoff = (size_t)u.pm * 256 * g.ld2 + 512 * 2; u.boff = (size_t)(768 + u.pn * 256) * g.ld2; }
        else { const int t = L - 224; u.pm = t & 3; u.pn = t >> 2; u.nt = 4; u.kind = EK_KVC; u.aoff = (size_t)(8192 + u.pm * 256) * g.ld2 + 512 * 2; u.boff = (size_t)(1792 + u.pn * 256) * g.ld2; }
        return true; }
    case GT_BR: {
        int rem = i, slot = -1;
        for (int j = 0;; ++j) { const int sl = j * G + c; if (sl >= 256) return false; const int n = sl < 128 ? 1 : 2; if (rem < n) { slot = sl; break; } rem -= n; }
        if (slot < 128) { u.pm = slot & 31; u.pn = slot >> 5; u.nt = 16; u.kind = EK_BR1; u.aoff = (size_t)u.pm * 256 * g.ld2; u.boff = (size_t)u.pn * 256 * g.ld2; return true; }
        { const int t = slot - 128; u.pm = t & 31; u.pn = t >> 5; u.nt = 8; const int koff = (rem == 0) ? 1024 : 1536; u.kind = (rem == 0) ? EK_BR0 : EK_BR2;
          u.aoff = (size_t)u.pm * 256 * g.ld2 + (size_t)koff * 2; u.boff = (size_t)u.pn * 256 * g.ld2 + (size_t)koff * 2; }
        return true; }
    default: {
        if (L >= 256) return false;
        int pm, pe; tile_order(L, 32, 8, pm, pe);
        u.pm = pm; u.pn = pe >> 1; u.kz = pe & 1; u.nt = 16; u.kind = EK_F32;
        u.aoff = (size_t)pm * 256 * g.ld2 + (size_t)u.kz * 1024 * 2; u.boff = (size_t)u.pn * 256 * g.ld2 + (size_t)u.kz * 1024 * 2; return true; }
    }
}

__device__ __forceinline__ void rope4(f32x4& x1, f32x4& x2, int t, int fq) {
    const float pos = (float)((fq >> 1) ? (t & 63) : (t >> 6));
#pragma unroll
    for (int j = 0; j < 4; ++j) {
        const float fi = (float)(4 * (fq & 1) + j);
        const float ang = pos * exp2f(-fi * 1.6609640474f);
        const float cs = __cosf(ang), sn = __sinf(ang);
        const float a = x1[j], b = x2[j];
        x1[j] = a * cs - b * sn; x2[j] = a * sn + b * cs;
    }
}

__device__ __forceinline__ void epilogue(const Ctx& cx, const Args& a, int l, const f32x4 (&acc)[2][2][4][2], const Unit& u, LAS unsigned char* lds) {
    const int tid_e = otid(), wid_e = __builtin_amdgcn_readfirstlane(tid_e >> 6), wr = wid_e >> 2, wc = wid_e & 3, fr = tid_e & 15, fq = (tid_e & 63) >> 4;
    const int row0 = u.pm * 256 + wr * 64 + fr;
    const int cin0 = wc * 32 + 4 * fq;
    const int cP = wc * 32 + 8 * fq;
    switch (u.kind) {
    case EK_SWIGLU: {
#pragma unroll
        for (int ai = 0; ai < 2; ++ai)
#pragma unroll
            for (int m = 0; m < 4; ++m) {
                const int r = row0 + ai * 128 + m * 16;
                bf16_t* rowp = cx.ACT() + (size_t)r * 2816 + u.pn * 128 + cP;
                f32x4 v[2];
#pragma unroll
                for (int n = 0; n < 2; ++n) {
                    const f32x4 g = acc[ai][0][m][n], up = acc[ai][1][m][n];
#pragma unroll
                    for (int j = 0; j < 4; ++j) v[n][j] = silu(g[j]) * up[j];
                }
                *(u32x4*)rowp = pack8(v[0], v[1]);
            }
    } break;
    case EK_F32: {
#pragma unroll
        for (int ai = 0; ai < 2; ++ai)
#pragma unroll
            for (int m = 0; m < 4; ++m) {
                const int r = row0 + ai * 128 + m * 16;
                bf16_t* rowp = (bf16_t*)cx.F() + ((size_t)u.kz * NTOK + r) * 1024 + u.pn * 256 + cP;
#pragma unroll
                for (int bj = 0; bj < 2; ++bj) *(u32x4*)(rowp + bj * 128) = pack8(acc[ai][bj][m][0], acc[ai][bj][m][1]);
            }
    } break;
    case EK_MIXIN: {
        const int pn = u.pn;
        const int rowbase = (u.pm < 16) ? u.pm * 256 : 4096 + ((u.pm - 16) >> 2) * 1024;
        const int T = (u.pm < 16) ? 256 : 1024;
        if (pn < 4) {
#pragma unroll
            for (int ai = 0; ai < 2; ++ai)
#pragma unroll
                for (int m = 0; m < 4; ++m) {
                    const int r = row0 + ai * 128 + m * 16;
                    bf16_t* rowp = cx.HGLU() + (size_t)r * 512 + pn * 128 + cP;
                    f32x4 v[2];
#pragma unroll
                    for (int n = 0; n < 2; ++n) {
                        const f32x4 av = acc[ai][0][m][n], g = acc[ai][1][m][n];
#pragma unroll
                        for (int j = 0; j < 4; ++j) v[n][j] = av[j] * sigm(g[j]);
                    }
                    *(u32x4*)rowp = pack8(v[0], v[1]);
                }
        } else if (pn < 6) {
#pragma unroll
            for (int ai = 0; ai < 2; ++ai)
#pragma unroll
                for (int m = 0; m < 4; ++m) {
                    const int r = row0 + ai * 128 + m * 16;
                    bf16_t* rowp = cx.QR() + (size_t)r * 512 + (pn - 4) * 256 + cP;
#pragma unroll
                    for (int bj = 0; bj < 2; ++bj) *(u32x4*)(rowp + bj * 128) = pack8(acc[ai][bj][m][0], acc[ai][bj][m][1]);
                }
        } else if (pn < 8) {
            bf16_t* tb = cx.KRT() + (size_t)rowbase * 512;
#pragma unroll
            for (int ai = 0; ai < 2; ++ai)
#pragma unroll
                for (int m = 0; m < 4; ++m) {
                    const int r = row0 + ai * 128 + m * 16;
                    bf16_t* rowp = cx.KR() + (size_t)r * 512 + (pn - 6) * 256 + cin0;
#pragma unroll
                    for (int bj = 0; bj < 2; ++bj)
#pragma unroll
                        for (int n = 0; n < 2; ++n) {
                            const f32x4 v = acc[ai][bj][m][n] * 0.08838834764f;
                            const u32x2 w = pack4(v);
                            *(u32x2*)(rowp + bj * 128 + n * 16) = w;
                            const int col = (pn - 6) * 256 + bj * 128 + n * 16 + cin0;
                            bf16_t* tp = tb + (size_t)col * T + (r - rowbase);
                            tp[0] = (bf16_t)(w.x & 0xffffu); tp[(size_t)T] = (bf16_t)(w.x >> 16); tp[(size_t)2 * T] = (bf16_t)(w.y & 0xffffu); tp[(size_t)3 * T] = (bf16_t)(w.y >> 16);
                        }
                }
        } else if (pn < 12) {
            bf16_t* tb = cx.VRT() + (size_t)rowbase * 1024;
#pragma unroll
            for (int ai = 0; ai < 2; ++ai)
#pragma unroll
                for (int m = 0; m < 4; ++m) {
                    const int r = row0 + ai * 128 + m * 16;
#pragma unroll
                    for (int bj = 0; bj < 2; ++bj)
#pragma unroll
                        for (int n = 0; n < 2; ++n) {
                            const u32x2 w = pack4(acc[ai][bj][m][n]);
                            const int col = (pn - 8) * 256 + bj * 128 + n * 16 + cin0;
                            bf16_t* tp = tb + (size_t)col * T + (r - rowbase);
                            tp[0] = (bf16_t)(w.x & 0xffffu); tp[(size_t)T] = (bf16_t)(w.x >> 16); tp[(size_t)2 * T] = (bf16_t)(w.y & 0xffffu); tp[(size_t)3 * T] = (bf16_t)(w.y >> 16);
                        }
                }
        } else if (pn < 16) {
#pragma unroll
            for (int ai = 0; ai < 2; ++ai)
#pragma unroll
                for (int m = 0; m < 4; ++m) {
                    const int r = row0 + ai * 128 + m * 16;
                    bf16_t* rowp = cx.GR() + (size_t)r * 1024 + (pn - 12) * 256 + cP;
#pragma unroll
                    for (int bj = 0; bj < 2; ++bj) { f32x4 v[2];
#pragma unroll
                        for (int n = 0; n < 2; ++n) { const f32x4 x = acc[ai][bj][m][n];
#pragma unroll
                            for (int j = 0; j < 4; ++j) v[n][j] = silu(x[j]); }
                        *(u32x4*)(rowp + bj * 128) = pack8(v[0], v[1]); }
                }
        } else if (pn < 19) {
            const bool isq = pn < 18;
#pragma unroll
            for (int ai = 0; ai < 2; ++ai)
#pragma unroll
                for (int m = 0; m < 4; ++m) {
                    const int r = row0 + ai * 128 + m * 16;
                    bf16_t* rowp = cx.MQKV() + (size_t)r * 768 + (pn - 16) * 256 + cin0;
                    float s = 0.f;
#pragma unroll
                    for (int bj = 0; bj < 2; ++bj)
#pragma unroll
                        for (int n = 0; n < 2; ++n) { const f32x4 x = acc[ai][bj][m][n]; s += (x[0] * x[0] + x[1] * x[1]) + (x[2] * x[2] + x[3] * x[3]);
                            *(u32x2*)(rowp + bj * 128 + n * 16) = pack4(x); }
                    s += __shfl_xor(s, 16); s += __shfl_xor(s, 32);
                    if (fq == 0) { if (isq) cx.SSQQ()[(size_t)r * 8 + (pn - 16) * 4 + wc] = s; else cx.SSQKV()[(size_t)r * 4 + wc] = s; }
                    if (!isq && r < 4096) {
                        float* o = cx.out + OUT_CKV + ((size_t)((r >> 8) * 2 + l) * 256 + (r & 255)) * 256 + cin0;
#pragma unroll
                        for (int bj = 0; bj < 2; ++bj)
#pragma unroll
                            for (int n = 0; n < 2; ++n) *(f32x4*)(o + bj * 128 + n * 16) = acc[ai][bj][m][n];
                    }
                }
        } else if (pn == 19) {
            if (wc == 0) {
#pragma unroll
                for (int ai = 0; ai < 2; ++ai)
#pragma unroll
                    for (int m = 0; m < 4; ++m) {
                        const int r = row0 + ai * 128 + m * 16;
                        f32x4 x1 = acc[ai][0][m][0], x2 = acc[ai][0][m][1];
                        size_t kr;
                        if (r < 4096) {
                            float* o = cx.out + OUT_KROPE + ((size_t)((r >> 8) * 2 + l) * 256 + (r & 255)) * 32 + (fq >> 1) * 16 + 4 * (fq & 1);
                            *(f32x4*)(o) = x1; *(f32x4*)(o + 8) = x2;
                            kr = (size_t)r;
                        } else {
                            const int rr = r - 4096, t = rr & 1023;
                            rope4(x1, x2, t, fq);
                            kr = (size_t)4096 + (size_t)(rr >> 10) * 1280 + 256 + t;
                        }
                        bf16_t* kp = cx.KROPE() + kr * 32 + 4 * fq;
                        *(u32x2*)(kp) = pack4(x1); *(u32x2*)(kp + 16) = pack4(x2);
                    }
            }
        } else {
#pragma unroll
            for (int ai = 0; ai < 2; ++ai)
#pragma unroll
                for (int m = 0; m < 4; ++m) {
                    const int r = row0 + ai * 128 + m * 16;
                    bf16_t* rowp = cx.BG() + (size_t)r * 3072 + (pn - 20) * 256 + cP;
#pragma unroll
                    for (int bj = 0; bj < 2; ++bj) { f32x4 v[2];
#pragma unroll
                        for (int n = 0; n < 2; ++n) { const f32x4 x = acc[ai][bj][m][n];
#pragma unroll
                            for (int j = 0; j < 4; ++j) v[n][j] = sigm(x[j]); }
                        *(u32x4*)(rowp + bj * 128) = pack8(v[0], v[1]); }
                }
        }
    } break;
    case EK_QUP: {
#pragma unroll
        for (int ai = 0; ai < 2; ++ai)
#pragma unroll
            for (int m = 0; m < 4; ++m) {
                const int r = row0 + ai * 128 + m * 16;
                float rs;
                if (gridDim.x >= 240) rs = *(const LAS float*)(lds + RS_OFF + 4 * (wr * 64 + fr + ai * 128 + m * 16));
                else { const f32x4 s0 = *(const f32x4*)(cx.SSQQ() + (size_t)r * 8), s1 = *(const f32x4*)(cx.SSQQ() + (size_t)r * 8 + 4);
                       rs = rsqrtf((((s0[0] + s0[1]) + (s0[2] + s0[3])) + ((s1[0] + s1[1]) + (s1[2] + s1[3]))) * (1.0f / 512.0f) + 1e-6f) * QSCALE; }
                bf16_t* qrow = cx.Q() + (size_t)r * 768;
                if (u.pn < 2) {
#pragma unroll
                    for (int bj = 0; bj < 2; ++bj)
#pragma unroll
                        for (int n = 0; n < 2; ++n) {
                            const int col = u.pn * 256 + bj * 128 + n * 16 + cin0;
                            *(u32x2*)(qrow + (col >> 6) * 96 + (col & 63)) = pack4(acc[ai][bj][m][n] * rs);
                        }
                } else {
#pragma unroll
                    for (int bj = 0; bj < 2; ++bj) {
                        f32x4 x1 = acc[ai][bj][m][0] * rs, x2 = acc[ai][bj][m][1] * rs;
                        if (r >= 4096) rope4(x1, x2, (r - 4096) & 1023, fq);
                        bf16_t* qp = qrow + (4 * bj + wc) * 96 + 64 + 4 * fq;
                        *(u32x2*)(qp) = pack4(x1); *(u32x2*)(qp + 16) = pack4(x2);
                    }
                }
            }
    } break;
    case EK_KVUP:
    case EK_KVC: {
        const bool cache = (u.kind == EK_KVC);
        int kbase, Tk, joff;
        if (cache) { kbase = 4096 + 1280 * u.pm; Tk = 1280; joff = 0; }
        else if (u.pm < 16) { kbase = 256 * u.pm; Tk = 256; joff = 0; }
        else { const int b = (u.pm - 16) >> 2; kbase = 4096 + 1280 * b; Tk = 1280; joff = 256 + ((u.pm - 16) & 3) * 256; }
#pragma unroll
        for (int ai = 0; ai < 2; ++ai)
#pragma unroll
            for (int m = 0; m < 4; ++m) {
                const int lr_ = wr * 64 + fr + ai * 128 + m * 16;
                const int r = u.pm * 256 + lr_;
                float rs = 1.0f;
                if (!cache) {
                    if (gridDim.x >= 240) rs = *(const LAS float*)(lds + RS_OFF + 4 * lr_);
                    else { const f32x4 s0 = *(const f32x4*)(cx.SSQKV() + (size_t)r * 4); rs = rsqrtf(((s0[0] + s0[1]) + (s0[2] + s0[3])) * (1.0f / 256.0f) + 1e-6f); }
                }
                const int jpos = joff + lr_;
#pragma unroll
                for (int bj = 0; bj < 2; ++bj) {
                    const int head = 2 * u.pn + bj;
#pragma unroll
                    for (int n = 0; n < 2; ++n) {
                        const u32x2 w = pack4(acc[ai][bj][m][n] * rs);
                        if (wc < 2) {
                            *(u32x2*)(cx.KN() + (size_t)(kbase + jpos) * 512 + head * 64 + wc * 32 + n * 16 + 4 * fq) = w;
                        } else {
                            const int dv = (wc - 2) * 32 + n * 16 + 4 * fq;
                            bf16_t* tp = cx.VT() + (size_t)kbase * 512 + (size_t)(head * 64 + dv) * Tk + jpos;
                            tp[0] = (bf16_t)(w.x & 0xffffu); tp[(size_t)Tk] = (bf16_t)(w.x >> 16); tp[(size_t)2 * Tk] = (bf16_t)(w.y & 0xffffu); tp[(size_t)3 * Tk] = (bf16_t)(w.y >> 16);
                        }
                    }
                }
            }
    } break;
    case EK_BR0:
    case EK_BR1:
    case EK_BR2: {
        const int gofs = (u.kind == EK_BR0) ? 0 : (u.kind == EK_BR1 ? 1024 : 2048);
        __builtin_assume_separate_storage(cx.BG(), cx.MG()); __builtin_assume_separate_storage(cx.BG(), cx.SCR()); __builtin_assume_separate_storage(cx.SCR(), cx.MG());
#pragma unroll
        for (int ai = 0; ai < 2; ++ai)
#pragma unroll
            for (int m = 0; m < 4; ++m) {
                const int r = row0 + ai * 128 + m * 16;
                const int colb = u.pn * 256 + cP;
                u32x4 gw[2]; u32x4 sv[2];
#pragma unroll
                for (int bj = 0; bj < 2; ++bj) {
                    gw[bj] = *(const u32x4*)(cx.BG() + (size_t)r * 3072 + gofs + colb + bj * 128);
                    if (u.kind == EK_BR2) sv[bj] = *(const u32x4*)((const bf16_t*)cx.SCR() + (size_t)r * 1024 + colb + bj * 128);
                }
#pragma unroll
                for (int bj = 0; bj < 2; ++bj) {
                    const int col = colb + bj * 128;
                    const f32x4 g0 = (f32x4){bflo(gw[bj].x), bfhi(gw[bj].x), bflo(gw[bj].y), bfhi(gw[bj].y)}, g1 = (f32x4){bflo(gw[bj].z), bfhi(gw[bj].z), bflo(gw[bj].w), bfhi(gw[bj].w)};
                    f32x4 v0 = acc[ai][bj][m][0] * g0, v1 = acc[ai][bj][m][1] * g1;
                    if (u.kind == EK_BR0) { *(u32x4*)((bf16_t*)cx.SCR() + (size_t)r * 1024 + col) = pack8(v0, v1); }
                    else if (u.kind == EK_BR1) { *(u32x4*)(cx.MG() + (size_t)r * 2048 + col) = pack8(v0, v1); }
                    else { v0 += (f32x4){bflo(sv[bj].x), bfhi(sv[bj].x), bflo(sv[bj].y), bfhi(sv[bj].y)}; v1 += (f32x4){bflo(sv[bj].z), bfhi(sv[bj].z), bflo(sv[bj].w), bfhi(sv[bj].w)}; *(u32x4*)(cx.MG() + (size_t)r * 2048 + 1024 + col) = pack8(v0, v1); }
                }
            }
    } break;
    default: break;
    }
}

__device__ __forceinline__ void gemm_phase(LAS unsigned char* lds, const GemmCall g, const Ctx& cx, const Args& a, int l) {
    const int tid = otid(), wid = __builtin_amdgcn_readfirstlane(tid >> 6), lane = tid & 63, wr = wid >> 2, wc = wid & 3, fr = lane & 15, fq = lane >> 4;
    const int G = gridDim.x, cidx = blockIdx.x;
    unsigned voffA[2];
#pragma unroll
    for (int i = 0; i < 2; ++i) { int R, C; stage_rc(tid * 16 + i * 8192, R, C); voffA[i] = (unsigned)R * g.ld2 + (unsigned)C * 2u; }
    const size_t kstep = (size_t)(BK * 2);
    const size_t hstepA = (size_t)HALF * g.ld2;
    const unsigned ldsw = (unsigned)wid * 1024u;
    const int aoff = lds_byte(wr * 64 + fr, fq * 8), boff = lds_byte(wc * 32 + fr, fq * 8);
#define PG8_SA(b, h) (((b) * 2 + (h)) * HTB)
#define PG8_SB(b, h) ((4 + (b) * 2 + (h)) * HTB)
#define PG8_STAGE(bufoff, gbase, voff) do { _Pragma("unroll") for (int _i = 0; _i < 2; ++_i) \
        __builtin_amdgcn_global_load_lds((const unsigned*)((const char*)(gbase) + (voff)[_i]), (LAS unsigned*)(lds + (bufoff) + ldsw + _i * 8192), 16, 0, 0); } while (0)
#define PG8_LDA(dst, b, h) do { _Pragma("unroll") for (int m = 0; m < 4; ++m) _Pragma("unroll") for (int k = 0; k < 2; ++k) dst[m][k] = *(const LAS bf16x8*)(lds + PG8_SA(b, h) + aoff + m * 2048 + k * 1024); } while (0)
#define PG8_LDB(dst, b, h) do { _Pragma("unroll") for (int n = 0; n < 2; ++n) _Pragma("unroll") for (int k = 0; k < 2; ++k) dst[n][k] = *(const LAS bf16x8*)(lds + PG8_SB(b, h) + boff + n * 2048 + k * 1024); } while (0)
#define PG8_MMA(ai, bj, At, Bt) do { __builtin_amdgcn_s_setprio(1); _Pragma("unroll") for (int m = 0; m < 4; ++m) _Pragma("unroll") for (int n = 0; n < 2; ++n) _Pragma("unroll") for (int k = 0; k < 2; ++k) \
        acc[ai][bj][m][n] = __builtin_amdgcn_mfma_f32_16x16x32_bf16(Bt[n][k], At[m][k], acc[ai][bj][m][n], 0, 0, 0); __builtin_amdgcn_s_setprio(0); } while (0)
#define PG8_WAIT_V(n) asm volatile("s_waitcnt vmcnt(" #n ")" ::: "memory")
#define PG8_WAIT_L(n) asm volatile("s_waitcnt lgkmcnt(" #n ")" ::: "memory")
#define PG8_BAR __builtin_amdgcn_s_barrier()
#define PG8_SCHED __builtin_amdgcn_sched_barrier(0)
    Unit cur, nxt; int ui = 0;
    if (!sched_next(g, 0, cidx, G, cur)) return;
    f32x4 acc[2][2][4][2];
#pragma unroll
    for (int x = 0; x < 2; ++x)
#pragma unroll
        for (int b = 0; b < 2; ++b)
#pragma unroll
            for (int m = 0; m < 4; ++m)
#pragma unroll
                for (int n = 0; n < 2; ++n) acc[x][b][m][n] = (f32x4){0.f, 0.f, 0.f, 0.f};
    bf16x8 At[4][2], B0[2][2], B1[2][2];
    const char* cA = g.A + cur.aoff; const char* cB = g.Bt + cur.boff;
    PG8_STAGE(PG8_SB(0, 0), cB, voffA); PG8_STAGE(PG8_SA(0, 0), cA, voffA); PG8_STAGE(PG8_SB(0, 1), cB + hstepA, voffA); PG8_STAGE(PG8_SA(0, 1), cA + hstepA, voffA);
    if (wr == 1) PG8_BAR;
    PG8_WAIT_V(4); PG8_BAR;
    PG8_STAGE(PG8_SB(1, 0), cB + kstep, voffA); PG8_STAGE(PG8_SA(1, 0), cA + kstep, voffA); PG8_STAGE(PG8_SB(1, 1), cB + hstepA + kstep, voffA);
    PG8_WAIT_V(6); PG8_BAR;
    for (;;) {
        const bool has_next = sched_next(g, ui + 1, cidx, G, nxt);
        const char* nA = has_next ? g.A + nxt.aoff : cA; const char* nB = has_next ? g.Bt + nxt.boff : cB;
        const int nt = cur.nt;
        for (int t = 0; t < nt; t += 2) {
            const bool last = (t == nt - 2);
            const char* a1 = cA + (size_t)(t + 1) * kstep;
            const char* a2 = last ? nA : cA + (size_t)(t + 2) * kstep; const char* b2 = last ? nB : cB + (size_t)(t + 2) * kstep;
            const char* a3 = a2 + kstep; const char* b3 = b2 + kstep;
            PG8_LDB(B0, 0, 0); PG8_SCHED; PG8_LDA(At, 0, 0); PG8_STAGE(PG8_SA(1, 1), a1 + hstepA, voffA);
            PG8_WAIT_L(8); PG8_BAR; PG8_WAIT_L(0); PG8_MMA(0, 0, At, B0); PG8_BAR; PG8_SCHED;
            PG8_LDB(B1, 0, 1); PG8_STAGE(PG8_SB(0, 0), b2, voffA);
            PG8_BAR; PG8_WAIT_L(0); PG8_MMA(0, 1, At, B1); PG8_BAR;
            PG8_LDA(At, 0, 1); PG8_STAGE(PG8_SA(0, 0), a2, voffA);
            PG8_BAR; PG8_WAIT_L(0); PG8_MMA(1, 0, At, B0); PG8_BAR; PG8_SCHED;
            PG8_STAGE(PG8_SB(0, 1), b2 + hstepA, voffA);
            PG8_WAIT_V(6); PG8_BAR; PG8_MMA(1, 1, At, B1); PG8_BAR;
            PG8_LDB(B0, 1, 0); PG8_SCHED; PG8_LDA(At, 1, 0); PG8_STAGE(PG8_SA(0, 1), a2 + hstepA, voffA);
            PG8_WAIT_L(8); PG8_BAR; PG8_WAIT_L(0); PG8_MMA(0, 0, At, B0); PG8_BAR; PG8_SCHED;
            PG8_LDB(B1, 1, 1); PG8_STAGE(PG8_SB(1, 0), b3, voffA);
            PG8_BAR; PG8_WAIT_L(0); PG8_MMA(0, 1, At, B1); PG8_BAR;
            PG8_LDA(At, 1, 1); PG8_STAGE(PG8_SA(1, 0), a3, voffA);
            PG8_BAR; PG8_WAIT_L(0); PG8_MMA(1, 0, At, B0); PG8_BAR; PG8_SCHED;
            PG8_STAGE(PG8_SB(1, 1), b3 + hstepA, voffA);
            PG8_WAIT_V(6); PG8_BAR; PG8_MMA(1, 1, At, B1); PG8_BAR;
        }
        epilogue(cx, a, l, acc, cur, lds);
        if (!has_next) break;
#pragma unroll
        for (int x = 0; x < 2; ++x)
#pragma unroll
            for (int b = 0; b < 2; ++b)
#pragma unroll
                for (int m = 0; m < 4; ++m)
#pragma unroll
                    for (int n = 0; n < 2; ++n) acc[x][b][m][n] = (f32x4){0.f, 0.f, 0.f, 0.f};
        cur = nxt; cA = nA; cB = nB; ++ui;
    }
    PG8_WAIT_V(0);
    if (wr == 0) PG8_BAR;
    PG8_BAR;
#undef PG8_SA
#undef PG8_SB
#undef PG8_STAGE
#undef PG8_LDA
#undef PG8_LDB
#undef PG8_MMA
#undef PG8_WAIT_V
#undef PG8_WAIT_L
#undef PG8_BAR
#undef PG8_SCHED
}

__device__ __forceinline__ int rope_src(int dp) { const int n = dp >> 4, ip = dp & 15; return (ip >> 3) * 16 + n * 8 + (ip & 7); }
__device__ __forceinline__ int mixin_src_col(int n) {
    const int t = n >> 8, w = n & 255;
    if (t < 4) return (w >> 7) * 512 + t * 128 + (w & 127);
    if (t < 6) return 1024 + (t - 4) * 256 + w;
    if (t < 8) return 1536 + (t - 6) * 256 + w;
    if (t < 12) return 2048 + (t - 8) * 256 + w;
    if (t < 16) return 3072 + (t - 12) * 256 + w;
    if (t < 18) return 4096 + (t - 16) * 256 + w;
    if (t == 18) return 4608 + w;
    if (t == 19) return (w < 32) ? 4864 + rope_src(w) : -1;
    return 4896 + (t - 20) * 256 + w;
}
constexpr int PREP_TILES = 352 + 176 + 352 + 176 + 512 + 24 + 16 + 16 + 128 + 128;

__device__ __forceinline__ void prep_tile(const Args& a, int l, int T, unsigned char* smem) {
    bf16_t* tile = (bf16_t*)smem;
    const int tid = otid(), nn = tid & 63, kq = tid >> 6;
    int job, t = T;
    if (t < 352) job = 0; else if ((t -= 352) < 176) job = 1; else if ((t -= 176) < 352) job = 2; else if ((t -= 352) < 176) job = 3;
    else if ((t -= 176) < 512) job = 4; else if ((t -= 512) < 24) job = 5; else if ((t -= 24) < 16) job = 6; else if ((t -= 16) < 16) job = 7;
    else if ((t -= 16) < 128) job = 8; else { t -= 128; job = 9; }
    const float* src = nullptr; const float* kscale = nullptr; size_t ld = 0; int ksrc0 = 0, col = 0, n0 = 0, k0 = 0; size_t ldd = 0; bf16_t* dst = nullptr;
    unsigned char* W = a.ws;
    switch (job) {
    case 0: case 2: { const int tk = t & 3, tn = t >> 2; n0 = tn * 64; k0 = tk * 256; const int n = ((n0 + nn) & ~31) + perm32((n0 + nn) & 31);
        src = a.in[job == 0 ? I_F1IN : I_F2IN] + (size_t)l * 1024 * 5632; ld = 5632; ksrc0 = k0;
        col = ((n & 255) >> 7) * 2816 + (n >> 8) * 128 + (n & 127); dst = (bf16_t*)(W + (job == 0 ? W_FFN1_IN : W_FFN2_IN)); ldd = 1024; } break;
    case 1: case 3: { const int tk = t % 11, tn = t / 11; n0 = tn * 64; k0 = tk * 256;
        src = a.in[job == 1 ? I_F1OUT : I_F2OUT] + (size_t)l * 2816 * 1024; ld = 1024; ksrc0 = k0; col = ((n0 + nn) & ~31) + perm32((n0 + nn) & 31);
        dst = (bf16_t*)(W + (job == 1 ? W_FFN1_OUT : W_FFN2_OUT)); ldd = 2816; } break;
    case 4: { const int tk = t & 3, tn = t >> 2; n0 = tn * 64; k0 = tk * 256;
        src = a.in[I_MIXIN] + (size_t)l * 1024 * 7968; ld = 7968; ksrc0 = k0; { const int n = n0 + nn, tt = n >> 8; const bool pm_ = (tt < 6) || (tt >= 12 && tt < 16) || (tt >= 20); col = mixin_src_col(pm_ ? (n & ~31) + perm32(n & 31) : n); } dst = (bf16_t*)(W + W_MIX_IN); ldd = 1024; } break;
    case 5: { const int tk = t & 1, tn = t >> 1; n0 = tn * 64; k0 = tk * 256; const int n = n0 + nn, tt = n >> 8, w = n & 255;
        src = a.in[I_WUQ] + (size_t)l * 512 * 768; ld = 768; ksrc0 = k0; kscale = a.in[I_QNORM] + l * 512;
        col = (tt < 2) ? (4 * tt + (w >> 6)) * 96 + (w & 63) : (w >> 5) * 96 + 64 + rope_src(w & 31);
        dst = (bf16_t*)(W + W_M2); ldd = 768; } break;
    case 6: case 7: { n0 = t * 64; k0 = 0;
        src = a.in[I_WUKV] + (size_t)l * 256 * 1024; ld = 1024; ksrc0 = 0; col = n0 + nn; if (job == 6) kscale = a.in[I_KVNORM] + l * 256;
        dst = (bf16_t*)(W + W_M2) + (size_t)(job == 6 ? 768 : 1792) * 768; ldd = 768; } break;
    case 8: { const int tk = t & 7, tn = t >> 3; n0 = tn * 64; k0 = tk * 256; col = ((n0 + nn) & ~31) + perm32((n0 + nn) & 31); ld = 1024;
        if (k0 < 1024) { src = a.in[I_RWOUT] + (size_t)l * 1024 * 1024; ksrc0 = k0; }
        else if (k0 < 1536) { src = a.in[I_CWOUT] + (size_t)l * 512 * 1024; ksrc0 = k0 - 1024; }
        else { src = a.in[I_MWOUT] + (size_t)l * 512 * 1024; ksrc0 = k0 - 1536; }
        dst = (bf16_t*)(W + W_BR); ldd = 2048; } break;
    default: { const int tk = t & 7, tn = t >> 3; n0 = tn * 64; k0 = tk * 256; col = ((n0 + nn) & ~31) + perm32((n0 + nn) & 31); ld = 1024;
        src = a.in[I_WO] + (size_t)l * 1024 * 1024; ksrc0 = k0 & 1023; dst = (bf16_t*)(W + W_O2); ldd = 2048; } break;
    }
    {
        const float* sp = src + (size_t)ksrc0 * ld + (col >= 0 ? col : 0);
        float v0[16], v1[16];
#pragma unroll
        for (int i = 0; i < 16; ++i) { const int kk = 2 * (kq + 8 * i); v0[i] = sp[(size_t)kk * ld]; v1[i] = sp[(size_t)(kk + 1) * ld]; }
#pragma unroll
        for (int i = 0; i < 16; ++i) {
            const int kk = 2 * (kq + 8 * i);
            float x0 = v0[i], x1 = v1[i];
            if (kscale) { x0 *= kscale[ksrc0 + kk]; x1 *= kscale[ksrc0 + kk + 1]; }
            if (col < 0) { x0 = 0.f; x1 = 0.f; }
            *(unsigned*)(tile + nn * 264 + kk) = cvt_pk_bf16(x0, x1);
        }
    }
    __syncthreads();
#pragma unroll
    for (int j = 0; j < 4; ++j) {
        const int idx = tid + 512 * j, nn2 = idx >> 5, kk8 = (idx & 31) * 8;
        *(u32x4*)(dst + (size_t)(n0 + nn2) * ldd + k0 + kk8) = *(const u32x4*)(tile + nn2 * 264 + kk8);
    }
    __syncthreads();
}

__device__ __forceinline__ void ada_phase(const Args& a, const Ctx& cx, unsigned char* smem) {
    float* sl = (float*)smem;
    float* red = (float*)(smem + 20480);
    const int tid = otid();
    for (int e = tid; e < 5 * 1024; e += 512) { const int ci = e >> 10, k = e & 1023; const float x = (ci == 0) ? a.in[I_CCTX][k] : a.in[I_C][(ci - 1) * 1024 + k]; sl[e] = silu(x); }
    __syncthreads();
    const int cgp = tid & 15, kg = tid >> 4;
    for (int task = (int)gridDim.x - 1 - (int)blockIdx.x; task < 288; task += gridDim.x) {
        const int l = task / 144, col0 = (task % 144) * 64;
        f32x4 acc[5];
#pragma unroll
        for (int ci = 0; ci < 5; ++ci) acc[ci] = (f32x4){0.f, 0.f, 0.f, 0.f};
        const float* wp = a.in[I_ADAW] + ((size_t)l * 1024 + kg * 32) * 9216 + col0 + cgp * 4;
#pragma unroll 4
        for (int kk = 0; kk < 32; ++kk) {
            const f32x4 w = *(const f32x4*)(wp + (size_t)kk * 9216);
#pragma unroll
            for (int ci = 0; ci < 5; ++ci) acc[ci] += w * sl[ci * 1024 + kg * 32 + kk];
        }
#pragma unroll
        for (int ci = 0; ci < 5; ++ci) *(f32x4*)(red + (kg * 5 + ci) * 64 + cgp * 4) = acc[ci];
        __syncthreads();
        if (tid < 320) {
            const int ci = tid >> 6, cc = tid & 63; float s = 0.f;
            for (int k2 = 0; k2 < 32; ++k2) s += red[(k2 * 5 + ci) * 64 + cc];
            cx.MOD()[((size_t)l * 5 + ci) * 9216 + col0 + cc] = s + a.in[I_ADAB][(size_t)l * 9216 + col0 + cc];
        }
        __syncthreads();
    }
}

#ifndef LN_NR
#define LN_NR 4
#endif
__device__ __forceinline__ void ln_phase(const Args& a, const Ctx& cx, int l, int s) {
    const int tid_ = otid(), lane = tid_ & 63, wave = tid_ >> 6;
    float* X = cx.out;
    const int nl = (s < 0) ? 0 : (s == 2 ? l + 1 : l), nm = (s < 0) ? 0 : (s == 2 ? 0 : 3 * (s + 1));
    const bool have_h = (nl < 2);
    const int rstride = gridDim.x * 8;
    for (int row0 = blockIdx.x * 8 + wave; row0 < NTOK; row0 += LN_NR * rstride) {
        f32x4 xn[LN_NR][4];
        int rows[LN_NR], cis[LN_NR];
#pragma unroll
        for (int rr = 0; rr < LN_NR; ++rr) { int r = row0 + rr * rstride; if (r >= NTOK) r = row0; rows[rr] = r; cis[rr] = r < 4096 ? 0 : 1 + ((r - 4096) >> 10); }
        if (s < 0) {
#pragma unroll
            for (int rr = 0; rr < LN_NR; ++rr) {
                const int row = rows[rr];
                const float* xp = (row < 4096) ? a.in[I_XP] + (size_t)row * 1024 : a.in[I_XS] + (size_t)(row - 4096) * 1024;
#pragma unroll
                for (int q = 0; q < 4; ++q) xn[rr][q] = *(const f32x4*)(xp + q * 256 + lane * 4);
            }
        } else {
            const float gs = (s == 1) ? 1.0f : 0.5f;
            float sum[LN_NR]; for (int rr = 0; rr < LN_NR; ++rr) sum[rr] = 0.f;
#pragma unroll
            for (int rr = 0; rr < LN_NR; ++rr) {
                const int row = rows[rr];
                const float* modl = cx.MOD() + ((size_t)l * 5 + cis[rr]) * 9216 + (3 * s + 2) * 1024;
                const float* xres = (l == 0 && s == 0) ? ((row < 4096) ? a.in[I_XP] + (size_t)row * 1024 : a.in[I_XS] + (size_t)(row - 4096) * 1024) : X + (size_t)row * 1024;
                const bf16_t* f0 = (const bf16_t*)cx.F() + (size_t)row * 1024; const bf16_t* f1 = (const bf16_t*)cx.F() + ((size_t)NTOK + row) * 1024;
#pragma unroll
                for (int q = 0; q < 4; ++q) {
                    const int c = q * 256 + lane * 4;
                    const f32x4 xo = *(const f32x4*)(xres + c), g = *(const f32x4*)(modl + c), p0 = unpack4(*(const u32x2*)(f0 + c)), p1 = unpack4(*(const u32x2*)(f1 + c));
                    xn[rr][q] = xo * ALPHA + (g * gs) * (p0 + p1);
                    sum[rr] += (xn[rr][q][0] + xn[rr][q][1]) + (xn[rr][q][2] + xn[rr][q][3]);
                }
            }
            const float* lg = a.in[I_LNG] + (size_t)(l * 3 + s) * 1024; const float* lb = a.in[I_LNB] + (size_t)(l * 3 + s) * 1024;
#pragma unroll
            for (int rr = 0; rr < LN_NR; ++rr) {
                const float mean = wave_sum(sum[rr]) * (1.0f / 1024.0f);
                float sq = 0.f;
#pragma unroll
                for (int q = 0; q < 4; ++q) { xn[rr][q] = xn[rr][q] - mean; sq += (xn[rr][q][0] * xn[rr][q][0] + xn[rr][q][1] * xn[rr][q][1]) + (xn[rr][q][2] * xn[rr][q][2] + xn[rr][q][3] * xn[rr][q][3]); }
                const float rstd = rsqrtf(wave_sum(sq) * (1.0f / 1024.0f) + 1e-5f);
#pragma unroll
                for (int q = 0; q < 4; ++q) {
                    const int c = q * 256 + lane * 4;
                    xn[rr][q] = xn[rr][q] * rstd * *(const f32x4*)(lg + c) + *(const f32x4*)(lb + c);
                    *(f32x4*)(X + (size_t)rows[rr] * 1024 + c) = xn[rr][q];
                }
            }
        }
        if (have_h) {
#pragma unroll
            for (int rr = 0; rr < LN_NR; ++rr) {
                const float* mn = cx.MOD() + ((size_t)nl * 5 + cis[rr]) * 9216 + nm * 1024;
#pragma unroll
                for (int q = 0; q < 4; ++q) {
                    const int c = q * 256 + lane * 4;
                    const f32x4 sh = *(const f32x4*)(mn + c), sc = *(const f32x4*)(mn + 1024 + c);
                    *(u32x2*)(cx.H() + (size_t)rows[rr] * 1024 + c) = pack4(xn[rr][q] * (sc + 1.0f) + sh);
                }
            }
        }
    }
}

__device__ __forceinline__ void cache_prep(const Args& a, const Ctx& cx, int l) {
    const size_t gtid = (size_t)blockIdx.x * 512 + otid(), gsz = (size_t)gridDim.x * 512;
    for (size_t e = gtid; e < 1024 * 64; e += gsz) {
        const int rr = (int)(e >> 6), c4 = (int)(e & 63) * 4, b = rr >> 8, t = rr & 255;
        const f32x4 v = *(const f32x4*)(a.in[I_CKV] + (((size_t)b * 2 + l) * 256 + t) * 256 + c4);
        *(u32x2*)(cx.MQKV() + (size_t)(8192 + rr) * 768 + 512 + c4) = pack4(v);
    }
    for (size_t e = gtid; e < 1024 * 32; e += gsz) {
        const int rr = (int)(e >> 5), dp = (int)(e & 31), b = rr >> 8, t = rr & 255;
        const float v = a.in[I_CKR][(((size_t)b * 2 + l) * 256 + t) * 32 + rope_src(dp)];
        cx.KROPE()[(size_t)(4096 + 1280 * b + t) * 32 + dp] = f2bf(v);
    }
    for (size_t e = gtid; e < (size_t)16 * 2 * 32768; e += gsz) {
        const int dv = (int)(e & 255), dk = (int)((e >> 8) & 127), dir = (int)((e >> 15) & 1), bh = (int)(e >> 16), b = bh >> 2, h = bh & 3;
        const float v = a.in[dir ? I_SB : I_SF][((((size_t)b * 2 + l) * 4 + h) * 128 + dk) * 256 + dv];
        cx.S0T()[((size_t)bh * 2 + dir) * 32768 + (size_t)dv * 128 + dk] = v;
    }
}

__device__ __forceinline__ void conv_rows(const Args& a, const Ctx& cx, int l, unsigned char* smem) {
    const int tid_ = otid(), lane = tid_ & 63, wave = tid_ >> 6;
    float* wl = (float*)smem;
    {
        const float* wsrc = a.in[I_CWDW] + (size_t)l * 31 * 512;
        for (int e = tid_; e < 31 * 128; e += 512) *(f32x4*)(wl + e * 4) = *(const f32x4*)(wsrc + e * 4);
    }
    __syncthreads();
    for (int rgp = blockIdx.x * 8 + wave; rgp < NTOK / 4; rgp += gridDim.x * 8) {
        const int row0 = rgp * 4;
        int rowbase, T, t0;
        if (row0 < 4096) { rowbase = row0 & ~255; t0 = row0 & 255; T = 256; } else { rowbase = 4096 + ((row0 - 4096) & ~1023); t0 = (row0 - 4096) & 1023; T = 1024; }
        f32x4 c0[4], c1[4];
#pragma unroll
        for (int i = 0; i < 4; ++i) { c0[i] = *(const f32x4*)(a.in[I_CBDW] + l * 512 + lane * 8); c1[i] = *(const f32x4*)(a.in[I_CBDW] + l * 512 + lane * 8 + 4); }
#pragma unroll
        for (int jc = 0; jc < 5; ++jc) {
            u32x4 raw[8]; float vld[8];
#pragma unroll
            for (int jj = 0; jj < 8; ++jj) {
                const int j = jc * 8 + jj;
                if (j < 34) {
                    const int tt = t0 - 15 + j;
                    const int ttc = tt < 0 ? 0 : (tt >= T ? T - 1 : tt);
                    vld[jj] = (tt >= 0 && tt < T) ? 1.0f : 0.0f;
                    raw[jj] = *(const u32x4*)(cx.HGLU() + (size_t)(rowbase + ttc) * 512 + lane * 8);
                }
            }
#pragma unroll
            for (int jj = 0; jj < 8; ++jj) {
                const int j = jc * 8 + jj;
                if (j < 34) {
                    const f32x4 x0 = (f32x4){bflo(raw[jj].x), bfhi(raw[jj].x), bflo(raw[jj].y), bfhi(raw[jj].y)} * vld[jj];
                    const f32x4 x1 = (f32x4){bflo(raw[jj].z), bfhi(raw[jj].z), bflo(raw[jj].w), bfhi(raw[jj].w)} * vld[jj];
#pragma unroll
                    for (int i = 0; i < 4; ++i) {
                        const int tap = j - i;
                        if (tap >= 0 && tap < 31) {
                            c0[i] += x0 * *(const f32x4*)(wl + tap * 512 + lane * 8);
                            c1[i] += x1 * *(const f32x4*)(wl + tap * 512 + lane * 8 + 4);
                        }
                    }
                }
            }
        }
        const float* lg = a.in[I_CLNG] + l * 512 + lane * 8; const float* lb = a.in[I_CLNB] + l * 512 + lane * 8;
        const f32x4 g0 = *(const f32x4*)(lg), g1 = *(const f32x4*)(lg + 4), b0 = *(const f32x4*)(lb), b1 = *(const f32x4*)(lb + 4);
#pragma unroll
        for (int i = 0; i < 4; ++i) {
            f32x4 y0 = c0[i], y1 = c1[i];
            const float mean = wave_sum((y0[0] + y0[1]) + (y0[2] + y0[3]) + (y1[0] + y1[1]) + (y1[2] + y1[3])) * (1.0f / 512.0f);
            y0 = y0 - mean; y1 = y1 - mean;
            const float var = wave_sum((y0[0] * y0[0] + y0[1] * y0[1]) + (y0[2] * y0[2] + y0[3] * y0[3]) + (y1[0] * y1[0] + y1[1] * y1[1]) + (y1[2] * y1[2] + y1[3] * y1[3])) * (1.0f / 512.0f);
            const float rstd = rsqrtf(var + 1e-5f);
            y0 = y0 * rstd * g0 + b0; y1 = y1 * rstd * g1 + b1;
#pragma unroll
            for (int j = 0; j < 4; ++j) { y0[j] = silu(y0[j]); y1[j] = silu(y1[j]); }
            u32x4 w; w.x = cvt_pk_bf16(y0[0], y0[1]); w.y = cvt_pk_bf16(y0[2], y0[3]); w.z = cvt_pk_bf16(y1[0], y1[1]); w.w = cvt_pk_bf16(y1[2], y1[3]);
            *(u32x4*)(cx.BR() + (size_t)(row0 + i) * 2048 + 1024 + lane * 8) = w;
        }
    }
    __syncthreads();
}

__device__ __forceinline__ void ckv_out_rows(const Args& a, const Ctx& cx, int l) {
    const int tid_ = otid(), lane = tid_ & 63, wave = tid_ >> 6;
    const f32x4 g = *(const f32x4*)(a.in[I_KVNORM] + l * 256 + lane * 4);
    for (int row = blockIdx.x * 8 + wave; row < 4096; row += gridDim.x * 8) {
        const f32x4 s0 = *(const f32x4*)(cx.SSQKV() + (size_t)row * 4);
        const float rs = rsqrtf(((s0[0] + s0[1]) + (s0[2] + s0[3])) * (1.0f / 256.0f) + 1e-6f);
        float* o = cx.out + OUT_CKV + ((size_t)((row >> 8) * 2 + l) * 256 + (row & 255)) * 256 + lane * 4;
        *(f32x4*)o = *(const f32x4*)o * rs * g;
    }
}

struct RetUnit { int rowbase, T, h, c, bh; bool ctx; };
__device__ __forceinline__ RetUnit ret_decode(int u) {
    RetUnit r;
    if (u < 128) { r.ctx = true; r.bh = u >> 1; r.h = (u & 7) >> 1; r.c = u & 1; r.rowbase = (u >> 3) * 256; r.T = 256; }
    else { const int v = u - 128; r.ctx = false; r.bh = v >> 3; r.h = (v & 31) >> 3; r.c = v & 7; r.rowbase = 4096 + (v >> 5) * 1024; r.T = 1024; }
    return r;
}
__device__ __forceinline__ float log2_sigmoid(float x) { return -log2f(1.0f + expf(-x)); }

__device__ __forceinline__ void r1_unit(const Args& a, const Ctx& cx, int l, int u, unsigned char* smem) {
    const RetUnit ru = ret_decode(u);
    const int tid_ = otid(), lane = tid_ & 63, wave = tid_ >> 6, lr = lane & 15, lg = lane >> 4;
    const float lgf = log2_sigmoid(a.in[I_RDF][l * 4 + ru.h]), lgb = log2_sigmoid(a.in[I_RDB][l * 4 + ru.h]);
    const size_t T = (size_t)ru.T;
    const bf16_t* vT = cx.VRT() + (size_t)ru.rowbase * 1024 + (size_t)(ru.h * 256) * T + ru.c * 128;
    const bf16_t* kT = cx.KRT() + (size_t)ru.rowbase * 512 + (size_t)(ru.h * 128) * T + ru.c * 128;
    bf16_t* kTs = (bf16_t*)smem;
    bf16_t* vTs = (bf16_t*)(smem + 34816);
    {
        u32x4 kr[4], vr[8];
#pragma unroll
        for (int j = 0; j < 4; ++j) { const int idx = tid_ + 512 * j; kr[j] = *(const u32x4*)(kT + (size_t)(idx >> 4) * T + (idx & 15) * 8); }
#pragma unroll
        for (int j = 0; j < 8; ++j) { const int idx = tid_ + 512 * j; vr[j] = *(const u32x4*)(vT + (size_t)(idx >> 4) * T + (idx & 15) * 8); }
#pragma unroll
        for (int j = 0; j < 4; ++j) { const int idx = tid_ + 512 * j; *(u32x4*)(kTs + (idx >> 4) * 136 + (idx & 15) * 8) = kr[j]; }
#pragma unroll
        for (int j = 0; j < 8; ++j) { const int idx = tid_ + 512 * j; *(u32x4*)(vTs + (idx >> 4) * 136 + (idx & 15) * 8) = vr[j]; }
    }
    __syncthreads();
#pragma unroll 1
    for (int dir = 0; dir < 2; ++dir) {
        const float lgd = dir ? lgb : lgf;
        f32x4 acc[2][8];
#pragma unroll
        for (int mt = 0; mt < 2; ++mt)
#pragma unroll
            for (int nt = 0; nt < 8; ++nt) acc[mt][nt] = (f32x4){0.f, 0.f, 0.f, 0.f};
#pragma unroll
        for (int ks = 0; ks < 4; ++ks) {
            const int j0 = ks * 32 + lg * 8;
            float z[8];
#pragma unroll
            for (int e = 0; e < 8; ++e) z[e] = __builtin_amdgcn_exp2f((float)(dir ? (j0 + e) : 127 - (j0 + e)) * lgd);
            bf16x8 af[2];
#pragma unroll
            for (int mt = 0; mt < 2; ++mt) {
                const u32x4 raw = *(const u32x4*)(vTs + (wave * 32 + mt * 16 + lr) * 136 + j0);
                FragU f;
                f.u.x = cvt_pk_bf16(bflo(raw.x) * z[0], bfhi(raw.x) * z[1]); f.u.y = cvt_pk_bf16(bflo(raw.y) * z[2], bfhi(raw.y) * z[3]);
                f.u.z = cvt_pk_bf16(bflo(raw.z) * z[4], bfhi(raw.z) * z[5]); f.u.w = cvt_pk_bf16(bflo(raw.w) * z[6], bfhi(raw.w) * z[7]);
                af[mt] = f.v;
            }
#pragma unroll
            for (int nt = 0; nt < 8; ++nt) {
                const bf16x8 kf = *(const bf16x8*)(kTs + (nt * 16 + lr) * 136 + j0);
#pragma unroll
                for (int mt = 0; mt < 2; ++mt) acc[mt][nt] = MFMA16(kf, af[mt], acc[mt][nt]);
            }
        }
        float* o = cx.KVT() + ((size_t)u * 2 + dir) * 32768;
        if (ru.ctx) {
#pragma unroll
            for (int mt = 0; mt < 2; ++mt)
#pragma unroll
                for (int nt = 0; nt < 8; ++nt) *(f32x4*)(o + (wave * 32 + mt * 16 + lr) * 128 + nt * 16 + lg * 4) = acc[mt][nt];
        } else {
            bf16_t* ob = (bf16_t*)o;
#pragma unroll
            for (int mt = 0; mt < 2; ++mt)
#pragma unroll
                for (int nt = 0; nt < 8; ++nt) *(u32x2*)(ob + (wave * 32 + mt * 16 + lr) * 128 + nt * 16 + lg * 4) = pack4(acc[mt][nt]);
        }
    }
    __syncthreads();
}

__device__ __forceinline__ void r2_unit(const Args& a, const Ctx& cx, int l, int u, unsigned char* smem) {
    const RetUnit ru = ret_decode(u);
    const int tid = otid(), lane = tid & 63, wave = tid >> 6, lr = lane & 15, lg = lane >> 4;
    const float lgf = log2_sigmoid(a.in[I_RDF][l * 4 + ru.h]), lgb = log2_sigmoid(a.in[I_RDB][l * 4 + ru.h]);
    const size_t T = (size_t)ru.T;
    bf16_t* Sbuf = (bf16_t*)smem;
    bf16_t* Pw = (bf16_t*)(smem + 69632) + wave * (16 * 136);
    const int crow = ru.rowbase + ru.c * 128;
    const int il = wave * 16 + lr;
    bf16x8 qf[4];
#pragma unroll
    for (int ks = 0; ks < 4; ++ks) qf[ks] = ldfrag(cx.QR() + (size_t)(crow + il) * 512 + ru.h * 128 + ks * 32 + lg * 8);
    const bf16_t* vT = cx.VRT() + (size_t)ru.rowbase * 1024 + (size_t)(ru.h * 256) * T + ru.c * 128;
    {
        u32x4 kreg[4];
#pragma unroll
        for (int j = 0; j < 4; ++j) { const int idx = tid + 512 * j; kreg[j] = *(const u32x4*)(cx.KR() + (size_t)(crow + (idx >> 4)) * 512 + ru.h * 128 + (idx & 15) * 8); }
#pragma unroll
        for (int j = 0; j < 4; ++j) { const int idx = tid + 512 * j; *(u32x4*)(Sbuf + (idx >> 4) * 136 + (idx & 15) * 8) = kreg[j]; }
    }
    __syncthreads();
    u32x4 vreg[8];
#pragma unroll
    for (int j = 0; j < 8; ++j) { const int idx = tid + 512 * j; vreg[j] = *(const u32x4*)(vT + (size_t)(idx >> 4) * T + (idx & 15) * 8); }
#pragma unroll
    for (int nt = 0; nt < 8; ++nt) {
        f32x4 sa = (f32x4){0.f, 0.f, 0.f, 0.f};
#pragma unroll
        for (int ks = 0; ks < 4; ++ks) { const bf16x8 kf = *(const bf16x8*)(Sbuf + (nt * 16 + lr) * 136 + ks * 32 + lg * 8); sa = MFMA16(kf, qf[ks], sa); }
        f32x4 p;
#pragma unroll
        for (int rg = 0; rg < 4; ++rg) { const int j = nt * 16 + lg * 4 + rg, d = il - j; p[rg] = sa[rg] * __builtin_amdgcn_exp2f(d >= 0 ? (float)d * lgf : (float)(-d) * lgb); }
        *(u32x2*)(Pw + lr * 136 + nt * 16 + lg * 4) = pack4(p);
    }
    __syncthreads();
#pragma unroll
    for (int j = 0; j < 8; ++j) { const int idx = tid + 512 * j; *(u32x4*)(Sbuf + (idx >> 4) * 136 + (idx & 15) * 8) = vreg[j]; }
    bf16x8 pf[4];
#pragma unroll
    for (int ks = 0; ks < 4; ++ks) pf[ks] = *(const bf16x8*)(Pw + lr * 136 + ks * 32 + lg * 8);
    __syncthreads();
    f32x4 oacc[16];
#pragma unroll
    for (int nt2 = 0; nt2 < 16; ++nt2) {
        f32x4 o = (f32x4){0.f, 0.f, 0.f, 0.f};
#pragma unroll
        for (int ks = 0; ks < 4; ++ks) { const bf16x8 vf = *(const bf16x8*)(Sbuf + (nt2 * 16 + lr) * 136 + ks * 32 + lg * 8); o = MFMA16(vf, pf[ks], o); }
        oacc[nt2] = o;
    }
    const int nc = ru.ctx ? 2 : 8;
    for (int dir = 0; dir < 2; ++dir) {
        const bool have = ru.ctx ? (dir == 0 ? ru.c == 1 : ru.c == 0) : true;
        if (!have) continue;
        const float lgd = dir ? lgb : lgf;
        __syncthreads();
        {
            int nterm;
            if (ru.ctx) nterm = 1; else nterm = dir == 0 ? ru.c + 1 : nc - ru.c;
#pragma unroll 1
            for (int hf = 0; hf < 2; ++hf) {
                f32x4 sacc[8];
#pragma unroll
                for (int it = 0; it < 8; ++it) sacc[it] = (f32x4){0.f, 0.f, 0.f, 0.f};
                if (ru.ctx) {
                    const float* p = cx.KVT() + ((size_t)(dir == 0 ? u - 1 : u + 1) * 2 + dir) * 32768;
#pragma unroll
                    for (int it = 0; it < 8; ++it) sacc[it] = *(const f32x4*)(p + (size_t)((hf * 8 + it) * 512 + tid) * 4);
                } else {
                    {
                        const float* p = cx.S0T() + ((size_t)ru.bh * 2 + dir) * 32768;
                        const float w = exp2f((float)((dir == 0 ? ru.c : nc - 1 - ru.c) * 128) * lgd);
#pragma unroll
                        for (int it = 0; it < 8; ++it) sacc[it] = *(const f32x4*)(p + (size_t)((hf * 8 + it) * 512 + tid) * 4) * w;
                    }
                    for (int m = 1; m < nterm; m += 4) {
                        const bf16_t* p[4]; float w[4];
#pragma unroll
                        for (int q = 0; q < 4; ++q) {
                            const int mm = (m + q < nterm) ? m + q : m;
                            if (dir == 0) { p[q] = (const bf16_t*)(cx.KVT() + ((size_t)(u - ru.c + (mm - 1)) * 2 + 0) * 32768); w[q] = exp2f((float)((ru.c - mm) * 128) * lgd); }
                            else { p[q] = (const bf16_t*)(cx.KVT() + ((size_t)(u + mm) * 2 + 1) * 32768); w[q] = exp2f((float)((mm - 1) * 128) * lgd); }
                            if (m + q >= nterm) w[q] = 0.f;
                        }
                        u32x2 ldq[4][8];
#pragma unroll
                        for (int q = 0; q < 4; ++q)
#pragma unroll
                            for (int it = 0; it < 8; ++it) ldq[q][it] = *(const u32x2*)(p[q] + (size_t)((hf * 8 + it) * 512 + tid) * 4);
#pragma unroll
                        for (int q = 0; q < 4; ++q)
#pragma unroll
                            for (int it = 0; it < 8; ++it) sacc[it] += unpack4(ldq[q][it]) * w[q];
                    }
                }
#pragma unroll
                for (int it = 0; it < 8; ++it) { const int e4 = (hf * 8 + it) * 512 + tid; *(u32x2*)(Sbuf + (e4 >> 5) * 136 + (e4 & 31) * 4) = pack4(sacc[it]); }
            }
        }
        __syncthreads();
        const float xi = dir == 0 ? exp2f((float)(il + 1) * lgf) : exp2f((float)(128 - il) * lgb);
#pragma unroll
        for (int nt2 = 0; nt2 < 16; ++nt2) {
            f32x4 cacc = (f32x4){0.f, 0.f, 0.f, 0.f};
#pragma unroll
            for (int ks = 0; ks < 4; ++ks) { const bf16x8 sf = *(const bf16x8*)(Sbuf + (nt2 * 16 + lr) * 136 + ks * 32 + lg * 8); cacc = MFMA16(sf, qf[ks], cacc); }
            oacc[nt2] += cacc * xi;
        }
    }
    float sum = 0.f;
#pragma unroll
    for (int nt2 = 0; nt2 < 16; ++nt2) sum += (oacc[nt2][0] + oacc[nt2][1]) + (oacc[nt2][2] + oacc[nt2][3]);
    sum += __shfl_xor(sum, 16); sum += __shfl_xor(sum, 32);
    const float mean = sum * (1.0f / 256.0f);
    float sq = 0.f;
#pragma unroll
    for (int nt2 = 0; nt2 < 16; ++nt2) { oacc[nt2] = oacc[nt2] - mean; sq += (oacc[nt2][0] * oacc[nt2][0] + oacc[nt2][1] * oacc[nt2][1]) + (oacc[nt2][2] * oacc[nt2][2] + oacc[nt2][3] * oacc[nt2][3]); }
    sq += __shfl_xor(sq, 16); sq += __shfl_xor(sq, 32);
    const float rstd = rsqrtf(sq * (1.0f / 256.0f) + 1e-5f);
    const size_t row = (size_t)(crow + il);
    u32x2 gts[16];
#pragma unroll
    for (int nt2 = 0; nt2 < 16; ++nt2) gts[nt2] = *(const u32x2*)(cx.GR() + row * 1024 + ru.h * 256 + nt2 * 16 + lg * 4);
#pragma unroll
    for (int nt2 = 0; nt2 < 16; ++nt2) {
        const int col = ru.h * 256 + nt2 * 16 + lg * 4;
        *(u32x2*)(cx.BR() + row * 2048 + col) = pack4(oacc[nt2] * rstd * unpack4(gts[nt2]));
    }
    if (ru.ctx) {
        const int c = ru.c, s = u >> 3;
        float* o = cx.out + (c == 0 ? OUT_RF : OUT_RB) + ((size_t)(s * 2 + l) * 4 + ru.h) * 32768;
        const float* A = cx.KVT() + ((size_t)u * 2 + c) * 32768;
        const float* B = cx.KVT() + ((size_t)(c == 0 ? u + 1 : u - 1) * 2 + c) * 32768;
        const float w = exp2f(128.0f * (c == 0 ? lgf : lgb));
        float* Tt = (float*)smem;
#pragma unroll 1
        for (int q4 = 0; q4 < 4; ++q4) {
            __syncthreads();
            f32x4 va[4], vb[4];
#pragma unroll
            for (int j = 0; j < 4; ++j) { const int idx = tid + 512 * j, dvl = idx >> 5, dk4 = (idx & 31) * 4; va[j] = *(const f32x4*)(A + (q4 * 64 + dvl) * 128 + dk4); vb[j] = *(const f32x4*)(B + (q4 * 64 + dvl) * 128 + dk4); }
#pragma unroll
            for (int j = 0; j < 4; ++j) { const int idx = tid + 512 * j, dvl = idx >> 5, dk4 = (idx & 31) * 4; const f32x4 r = va[j] * w + vb[j];
                Tt[dvl * 129 + dk4] = r[0]; Tt[dvl * 129 + dk4 + 1] = r[1]; Tt[dvl * 129 + dk4 + 2] = r[2]; Tt[dvl * 129 + dk4 + 3] = r[3]; }
            __syncthreads();
#pragma unroll
            for (int j = 0; j < 4; ++j) { const int idx = tid + 512 * j, dk = idx >> 4, dq = (idx & 15) * 4;
                const f32x4 r = (f32x4){Tt[dq * 129 + dk], Tt[(dq + 1) * 129 + dk], Tt[(dq + 2) * 129 + dk], Tt[(dq + 3) * 129 + dk]};
                *(f32x4*)(o + dk * 256 + q4 * 64 + dq) = r; }
        }
    }
    __syncthreads();
}

__device__ __forceinline__ void attn_unit(const Ctx& cx, int uidx, unsigned char* smem) {
    const int tid = otid(), lane = tid & 63, wave = tid >> 6, lr = lane & 15, lg = lane >> 4;
    int qrow0, head, kbase, Tk;
    if (uidx < 256) { const int b = uidx >> 6; head = (uidx & 63) >> 3; qrow0 = 4096 + b * 1024 + (uidx & 7) * 128; kbase = 4096 + 1280 * b; Tk = 1280; }
    else { const int v = uidx - 256, b = v >> 4; head = (v & 15) >> 1; qrow0 = b * 256 + (v & 1) * 128; kbase = b * 256; Tk = 256; }
    constexpr int BUFB = 23552, KR_OFF = 9216, VT_OFF = 14336;
    bf16_t* Pw = (bf16_t*)(smem + 2 * BUFB) + wave * (16 * 72);
    const size_t row = (size_t)(qrow0 + wave * 16 + lr);
    bf16x8 qf[3];
#pragma unroll
    for (int ks = 0; ks < 3; ++ks) qf[ks] = ldfrag(cx.Q() + row * 768 + head * 96 + ks * 32 + lg * 8);
    const int r8 = tid >> 3, s8 = tid & 7, r4 = (tid >> 2) & 63, s4 = tid & 3;
    const bf16_t* gk = cx.KN() + (size_t)(kbase + r8) * 512 + head * 64 + s8 * 8;
    const bf16_t* gv = cx.VT() + (size_t)kbase * 512 + (size_t)(head * 64 + r8) * Tk + s8 * 8;
    const bf16_t* gr = cx.KROPE() + (size_t)(kbase + r4) * 32 + s4 * 8;
    const int lk = r8 * 72 + s8 * 8, lrp = r4 * 40 + s4 * 8;
    const int nkb = Tk / 64;
    u32x4 pk = *(const u32x4*)gk, pv = *(const u32x4*)gv, pr = *(const u32x4*)gr;
    {
        bf16_t* b0 = (bf16_t*)smem;
        *(u32x4*)(b0 + lk) = pk; *(u32x4*)(b0 + VT_OFF / 2 + lk) = pv; if (tid < 256) *(u32x4*)(b0 + KR_OFF / 2 + lrp) = pr;
    }
    __syncthreads();
    float m_run = -1e30f, l_part = 0.f;
    f32x4 oacc[4];
#pragma unroll
    for (int i = 0; i < 4; ++i) oacc[i] = (f32x4){0.f, 0.f, 0.f, 0.f};
    for (int kb = 0; kb < nkb; ++kb) {
        const bool more = kb + 1 < nkb;
        if (more) { const size_t k1 = (size_t)(kb + 1) * 64; pk = *(const u32x4*)(gk + k1 * 512); pv = *(const u32x4*)(gv + k1); pr = *(const u32x4*)(gr + k1 * 32); }
        const bf16_t* cb = (const bf16_t*)(smem + (kb & 1) * BUFB);
        f32x4 s[4];
#pragma unroll
        for (int nt = 0; nt < 4; ++nt) {
            const bf16x8 k0 = *(const bf16x8*)(cb + (nt * 16 + lr) * 72 + lg * 8), k1 = *(const bf16x8*)(cb + (nt * 16 + lr) * 72 + 32 + lg * 8),
                         k2 = *(const bf16x8*)(cb + KR_OFF / 2 + (nt * 16 + lr) * 40 + lg * 8);
            f32x4 z = (f32x4){0.f, 0.f, 0.f, 0.f};
            z = MFMA16(k0, qf[0], z); z = MFMA16(k1, qf[1], z); z = MFMA16(k2, qf[2], z);
            s[nt] = z;
        }
        float mx = -1e30f;
#pragma unroll
        for (int nt = 0; nt < 4; ++nt) mx = fmaxf(mx, fmaxf(fmaxf(s[nt][0], s[nt][1]), fmaxf(s[nt][2], s[nt][3])));
        mx = fmaxf(mx, __shfl_xor(mx, 16)); mx = fmaxf(mx, __shfl_xor(mx, 32));
        const float m_new = fmaxf(m_run, mx), alpha = __builtin_amdgcn_exp2f(m_run - m_new);
        m_run = m_new;
        float ps = 0.f;
#pragma unroll
        for (int nt = 0; nt < 4; ++nt) {
#pragma unroll
            for (int rg = 0; rg < 4; ++rg) { s[nt][rg] = __builtin_amdgcn_exp2f(s[nt][rg] - m_new); ps += s[nt][rg]; }
            *(u32x2*)(Pw + lr * 72 + nt * 16 + lg * 4) = pack4(s[nt]);
        }
        l_part = l_part * alpha + ps;
#pragma unroll
        for (int i = 0; i < 4; ++i) oacc[i] = oacc[i] * alpha;
        bf16x8 pf[2];
#pragma unroll
        for (int ks = 0; ks < 2; ++ks) pf[ks] = *(const bf16x8*)(Pw + lr * 72 + ks * 32 + lg * 8);
#pragma unroll
        for (int nt2 = 0; nt2 < 4; ++nt2)
#pragma unroll
            for (int ks = 0; ks < 2; ++ks) { const bf16x8 vf = *(const bf16x8*)(cb + VT_OFF / 2 + (nt2 * 16 + lr) * 72 + ks * 32 + lg * 8); oacc[nt2] = MFMA16(vf, pf[ks], oacc[nt2]); }
        if (more) {
            bf16_t* nb = (bf16_t*)(smem + ((kb + 1) & 1) * BUFB);
            *(u32x4*)(nb + lk) = pk; *(u32x4*)(nb + VT_OFF / 2 + lk) = pv; if (tid < 256) *(u32x4*)(nb + KR_OFF / 2 + lrp) = pr;
        }
        __syncthreads();
    }
    float lt = l_part + __shfl_xor(l_part, 16); lt += __shfl_xor(lt, 32);
    const float inv = 1.0f / lt;
#pragma unroll
    for (int nt2 = 0; nt2 < 4; ++nt2) *(u32x2*)(cx.BR() + row * 2048 + 1536 + head * 64 + nt2 * 16 + lg * 4) = pack4(oacc[nt2] * inv);
}

__device__ __forceinline__ void grid_barrier(unsigned* cnt, unsigned target) {
    asm volatile("s_waitcnt vmcnt(0) lgkmcnt(0)" ::: "memory");
    __syncthreads();
    if (threadIdx.x == 0) {
        __builtin_amdgcn_fence(__ATOMIC_RELEASE, "agent");
        asm volatile("s_waitcnt vmcnt(0)" ::: "memory");
        __hip_atomic_fetch_add(cnt, 1u, __ATOMIC_RELAXED, __HIP_MEMORY_SCOPE_AGENT);
        while (__hip_atomic_load(cnt, __ATOMIC_RELAXED, __HIP_MEMORY_SCOPE_AGENT) < target) __builtin_amdgcn_s_sleep(1);
        __builtin_amdgcn_fence(__ATOMIC_ACQUIRE, "agent");
        asm volatile("s_waitcnt vmcnt(0)" ::: "memory");
    }
    __syncthreads();
}

#define XB_XCNT(j)  (256  + 64 * (j))
#define XB_XSUB(j)  (1280 + 64 * (j))
#define XB_XGEN(j)  (2304 + 64 * (j))
#define XB_TOP      3328
#define XB_TOPGEN   3392
__device__ __forceinline__ unsigned xb_ld(unsigned* p)              { return __hip_atomic_load(p, __ATOMIC_RELAXED, __HIP_MEMORY_SCOPE_AGENT); }
__device__ __forceinline__ unsigned xb_add(unsigned* p, unsigned v) { return __hip_atomic_fetch_add(p, v, __ATOMIC_RELAXED, __HIP_MEMORY_SCOPE_AGENT); }
__device__ __forceinline__ unsigned xb_xcc_id() { return (unsigned)__builtin_amdgcn_s_getreg((3 << 11) | 20) & 0xFu; }
__device__ __forceinline__ void xcd_barrier(unsigned* bar, volatile unsigned* st) {
    asm volatile("s_waitcnt vmcnt(0) lgkmcnt(0)" ::: "memory");
    __syncthreads();
    if (threadIdx.x == 0) {
        const unsigned x = xb_xcc_id();
        unsigned nloc = st[0], nx = st[1];
        if (nloc == 0u) {
            unsigned cntx = 0u, mine = 0u;
#pragma unroll
            for (unsigned j = 0; j < 16; ++j) { const unsigned c = xb_ld(&bar[XB_XCNT(j)]); cntx += (c > 0u) ? 1u : 0u; mine = (j == x) ? c : mine; }
            nloc = mine > 0u ? mine : 1u; nx = cntx > 0u ? cntx : 1u; st[0] = nloc; st[1] = nx;
        }
        const unsigned old = xb_add(&bar[XB_XSUB(x)], 1u);
        const unsigned gen = old / nloc;
        if (old + 1u == (gen + 1u) * nloc) {
            __builtin_amdgcn_fence(__ATOMIC_RELEASE, "agent");
            asm volatile("s_waitcnt vmcnt(0)" ::: "memory");
            const unsigned og = xb_add(&bar[XB_TOP], 1u);
            const unsigned tg = og / nx;
            if (og + 1u == (tg + 1u) * nx) xb_add(&bar[XB_TOPGEN], 1u);
            else while (xb_ld(&bar[XB_TOPGEN]) == tg) __builtin_amdgcn_s_sleep(1);
            __builtin_amdgcn_fence(__ATOMIC_ACQUIRE, "agent");
            xb_add(&bar[XB_XGEN(x)], 1u);
            asm volatile("s_waitcnt vmcnt(0)" ::: "memory");
        } else {
            while (xb_ld(&bar[XB_XGEN(x)]) == gen) __builtin_amdgcn_s_sleep(1);
            __builtin_amdgcn_fence(__ATOMIC_ACQUIRE, "agent");
            asm volatile("s_waitcnt vmcnt(0)" ::: "memory");
        }
    }
    __syncthreads();
}

__global__ void __launch_bounds__(512) mk_fwd(Args a) {
    extern __shared__ __attribute__((aligned(16))) unsigned char smem[];
    Ctx cx;
    cx.ws = a.ws; cx.out = a.out;
    LAS unsigned char* lds = (LAS unsigned char*)smem;
    const int G = gridDim.x;
    unsigned* const gbar = (unsigned*)(a.ws + WS_BAR);
    unsigned bar_round = 0;
    if (a.ph_hi > 1000) cg::this_grid().sync();
    volatile unsigned* const bst = (volatile unsigned*)(smem + STAGE_BYTES);
    if (threadIdx.x == 0) { bst[0] = 0u; bst[1] = 0u; (void)xb_add(&gbar[XB_XCNT(xb_xcc_id())], 1u); }
    __syncthreads();
#define GRID_SYNC() do { ++bar_round; if (bar_round == 1u) grid_barrier(gbar, (unsigned)G); else xcd_barrier(gbar, bst); } while (0)

    for (int ph = a.ph_lo; ph < a.ph_hi; ++ph) {
        cx.ws = a.ws; cx.out = a.out; asm volatile("" : "+s"(cx.ws), "+s"(cx.out));
        int l = 0, k = -1;
        if (ph >= 2) { l = (ph - 2) / 12; k = (ph - 2) % 12; }
        const int nrep = 1 + ((MK_REPEAT_MASK >> (ph == 0 ? 12 : (ph == 1 ? 13 : k))) & 1);
        for (int rep = 0; rep < nrep; ++rep) {
        bool do_gemm = false; GemmCall g; g.A = nullptr; g.Bt = nullptr; g.ld2 = 0; g.gt = 0;
        if (ph == 0) {
            if (G == 256) {
                const int c = blockIdx.x;
                if (c < 224) for (int t = c; t < 1792; t += 224) prep_tile(a, 0, t, smem);
                else for (int t = 1792 + (c - 224); t < PREP_TILES; t += 32) prep_tile(a, 0, t, smem);
            } else {
                for (int t = blockIdx.x; t < PREP_TILES; t += G) prep_tile(a, 0, t, smem);
            }
            ada_phase(a, cx, smem);
        } else if (ph == 1) {
            ln_phase(a, cx, 0, -1);
        } else {
            switch (k) {
            case 0: do_gemm = true; g.A = (const char*)cx.H(); g.Bt = (const char*)(a.ws + W_FFN1_IN); g.ld2 = 2048; g.gt = GT_FFN_IN; break;
            case 1: do_gemm = true; g.A = (const char*)cx.ACT(); g.Bt = (const char*)(a.ws + W_FFN1_OUT); g.ld2 = 5632; g.gt = GT_FFN_OUT; break;
            case 2: ln_phase(a, cx, l, 0); break;
            case 3: cache_prep(a, cx, l); do_gemm = true; g.A = (const char*)cx.H(); g.Bt = (const char*)(a.ws + W_MIX_IN); g.ld2 = 2048; g.gt = GT_MIX_IN; break;
            case 4:
                conv_rows(a, cx, l, smem);
                ckv_out_rows(a, cx, l);
                for (int u = blockIdx.x; u < 256; u += G) r1_unit(a, cx, l, u, smem);
                do_gemm = true; g.A = (const char*)cx.MQKV(); g.Bt = (const char*)(a.ws + W_M2); g.ld2 = 1536; g.gt = GT_M2;
                if (G >= 240) {
                    Unit u0; const int t = otid();
                    if (sched_next(g, 0, blockIdx.x, G, u0) && t < 256) {
                        const int r = u0.pm * 256 + t; float rs = 1.0f;
                        if (u0.kind == EK_QUP) { const f32x4 s0 = *(const f32x4*)(cx.SSQQ() + (size_t)r * 8), s1 = *(const f32x4*)(cx.SSQQ() + (size_t)r * 8 + 4);
                            rs = rsqrtf((((s0[0] + s0[1]) + (s0[2] + s0[3])) + ((s1[0] + s1[1]) + (s1[2] + s1[3]))) * (1.0f / 512.0f) + 1e-6f) * QSCALE; }
                        else if (u0.kind == EK_KVUP) { const f32x4 s0 = *(const f32x4*)(cx.SSQKV() + (size_t)r * 4); rs = rsqrtf(((s0[0] + s0[1]) + (s0[2] + s0[3])) * (1.0f / 256.0f) + 1e-6f); }
                        *(float*)(smem + RS_OFF + 4 * t) = rs;
                    }
                }
                __syncthreads();
                g.A = (const char*)cx.MQKV(); g.Bt = (const char*)(a.ws + W_M2); g.ld2 = 1536; g.gt = GT_M2; break;
            case 5:
                for (int u = blockIdx.x; u < 256; u += G) r2_unit(a, cx, l, u, smem);
                for (int u = blockIdx.x; u < 512; u += G) attn_unit(cx, u, smem);
                break;
            case 6: do_gemm = true; g.A = (const char*)cx.BR(); g.Bt = (const char*)(a.ws + W_BR); g.ld2 = 4096; g.gt = GT_BR; break;
            case 7: do_gemm = true; g.A = (const char*)cx.MG(); g.Bt = (const char*)(a.ws + W_O2); g.ld2 = 4096; g.gt = GT_MIX_O; break;
            case 8: ln_phase(a, cx, l, 1); break;
            case 9: do_gemm = true; g.A = (const char*)cx.H(); g.Bt = (const char*)(a.ws + W_FFN2_IN); g.ld2 = 2048; g.gt = GT_FFN_IN; break;
            case 10: do_gemm = true; g.A = (const char*)cx.ACT(); g.Bt = (const char*)(a.ws + W_FFN2_OUT); g.ld2 = 5632; g.gt = GT_FFN_OUT; break;
            default:
                ln_phase(a, cx, l, 2);
                if (l == 0) {
                    if (G == 256) { for (int f = blockIdx.x; f < 784; f += G) prep_tile(a, 1, f < 528 ? 528 + f : 1624 + (f - 528), smem); }
                    else for (int t = blockIdx.x; t < PREP_TILES; t += G) prep_tile(a, 1, t, smem);
                }
                break;
            }
        }
        if (do_gemm) gemm_phase(lds, g, cx, a, l);
        if (G == 256 && ph >= 2 && k == 6 && l == 0 && rep == 0 && blockIdx.x < 128)
            for (int e = blockIdx.x; e < 1096; e += 128) prep_tile(a, 1, e < 528 ? e : e + 528, smem);
        if (rep + 1 < nrep) GRID_SYNC();
        }
        if (ph + 1 < a.ph_hi) GRID_SYNC();
        if ((MK_REPEAT_MASK >> 14) & 1) { if (ph == 5) for (int q = 0; q < 20; ++q) GRID_SYNC(); }
    }
}

constexpr int LDS_BYTES = STAGE_BYTES + 16 + 1024;

extern "C" void kernel_launch(void* const* d_in, const int* in_sizes, int n_in, void* d_out, int out_size, void* d_ws, size_t ws_size, hipStream_t stream) {
    static int grid = 0;
    if (grid == 0) {
        if (n_in != 31 || ws_size < WS_END) { fprintf(stderr, "kernel_launch: unexpected n_in %d or ws_size %zu (< %zu)\n", n_in, ws_size, (size_t)WS_END); grid = -1; return; }
        int dev = 0, cus = 0, per_cu = 0;
        hipGetDevice(&dev);
        hipDeviceGetAttribute(&cus, hipDeviceAttributeMultiprocessorCount, dev);
        if (hipFuncSetAttribute((const void*)mk_fwd, hipFuncAttributeMaxDynamicSharedMemorySize, LDS_BYTES) != hipSuccess) { fprintf(stderr, "kernel_launch: hipFuncSetAttribute failed\n"); grid = -1; return; }
        hipOccupancyMaxActiveBlocksPerMultiprocessor(&per_cu, (const void*)mk_fwd, 512, LDS_BYTES);
        (void)hipGetLastError();
        if (per_cu < 1 || cus < 1) { fprintf(stderr, "kernel_launch: per_cu %d cus %d\n", per_cu, cus); grid = -1; return; }
        grid = cus;
    }
    if (grid < 0) return;
    Args a{};
    for (int i = 0; i < 31; ++i) a.in[i] = (const float*)d_in[i];
    a.out = (float*)d_out; a.ws = (unsigned char*)d_ws;
#if MK_PER_PHASE
    for (int ph = 0; ph < MK_PH_HI; ++ph) {
        a.ph_lo = ph; a.ph_hi = ph + MK_DBG_SPAN;
        hipLaunchKernelGGL(mk_fwd, dim3(grid), dim3(512), LDS_BYTES, stream, a);
    }
#else
    a.ph_lo = 0; a.ph_hi = MK_PH_HI;
    (void)hipMemsetAsync((unsigned char*)d_ws + WS_BAR, 0, 16384, stream);
    void* args[] = {&a};
    hipError_t e = hipLaunchCooperativeKernel((const void*)mk_fwd, dim3(grid), dim3(512), args, LDS_BYTES, stream);
    if (e != hipSuccess) fprintf(stderr, "kernel_launch: cooperative launch failed: %s\n", hipGetErrorString(e));
#endif
}
```

```cpp
#include <hip/hip_runtime.h>
#include <hip/hip_cooperative_groups.h>
#include <cstdio>
namespace cg = cooperative_groups;

#ifndef MK_PER_PHASE
#define MK_PER_PHASE 0
#endif
#ifndef MK_DBG_SPAN
#define MK_DBG_SPAN 1
#endif
#ifndef MK_REPEAT_MASK
#define MK_REPEAT_MASK 0
#endif
#ifndef MK_PH_HI
#define MK_PH_HI 26
#endif

#define LAS __attribute__((address_space(3)))
typedef unsigned short bf16_t;
typedef short bf16x8 __attribute__((ext_vector_type(8)));
typedef float f32x4 __attribute__((ext_vector_type(4)));
typedef unsigned u32x4 __attribute__((ext_vector_type(4)));
typedef unsigned u32x2 __attribute__((ext_vector_type(2)));

constexpr int NTOK = 8192;
constexpr float ALPHA = 1.41421356237f;
constexpr float QSCALE = 0.10206207261f * 1.44269504089f;
constexpr int N_PHASES = 26;

constexpr size_t OUT_CKV = 8388608, OUT_KROPE = 10485760, OUT_RF = 10747904, OUT_RB = 14942208;

constexpr size_t MBy = 1u << 20;
constexpr size_t W_FFN1_IN = 0, W_FFN1_OUT = 11534336, W_FFN2_IN = 17301504, W_FFN2_OUT = 28835840, W_MIX_IN = 34603008,
                 W_M2 = 51380224, W_BR = 55705600, W_O2 = 59899904;
constexpr size_t WS_MOD = 62 * MBy, WS_SSQQ = 62 * MBy + 512 * 1024, WS_SSQKV = 62 * MBy + 768 * 1024;
constexpr size_t WS_BAR = 62 * MBy + 960 * 1024;
constexpr size_t WS_Z1 = 63 * MBy, WS_ACT = WS_Z1, WS_H = WS_Z1 + 48 * MBy, WS_KVT = WS_Z1;
constexpr size_t WS_Z2 = 127 * MBy, WS_F = WS_Z2, WS_BR = WS_Z2, WS_SCR = WS_Z2 + 32 * MBy, WS_Q = WS_Z2 + 32 * MBy,
                 WS_KN = WS_Z2 + 45 * MBy, WS_VT = WS_Z2 + 54 * MBy, WS_KROPE = WS_Z2 + 63 * MBy;
constexpr size_t WS_Z3 = 191 * MBy, WS_HGLU = WS_Z3, WS_QR = WS_Z3 + 8 * MBy, WS_KR = WS_Z3 + 16 * MBy, WS_KRT = WS_Z3 + 24 * MBy,
                 WS_VRT = WS_Z3 + 32 * MBy, WS_GR = WS_Z3 + 48 * MBy, WS_MQKV = WS_Z3 + 64 * MBy, WS_MG = WS_Z3;
constexpr size_t WS_BG = 269 * MBy, WS_S0T = 317 * MBy, WS_END = 321 * MBy;

struct Args {
    const float* in[31];
    float* out;
    unsigned char* ws;
    int ph_lo, ph_hi;
};
enum { I_XP = 0, I_XS, I_CKV, I_CKR, I_SF, I_SB, I_C, I_CCTX, I_ADAW, I_ADAB, I_F1IN, I_F1OUT, I_F2IN, I_F2OUT, I_LNG, I_LNB, I_MIXIN,
       I_CWDW, I_CBDW, I_CLNG, I_CLNB, I_CWOUT, I_RDF, I_RDB, I_RWOUT, I_QNORM, I_WUQ, I_KVNORM, I_WUKV, I_MWOUT, I_WO };

typedef float f32x2_t __attribute__((ext_vector_type(2)));
typedef __bf16 bf16x2_t __attribute__((ext_vector_type(2)));
__device__ __forceinline__ unsigned cvt_pk_bf16(float lo, float hi) { const f32x2_t v = {lo, hi}; return __builtin_bit_cast(unsigned, __builtin_convertvector(v, bf16x2_t)); }
__device__ __forceinline__ bf16_t f2bf(float x) { return (bf16_t)(cvt_pk_bf16(x, 0.f) & 0xffffu); }
__device__ __forceinline__ float bflo(unsigned w) { return __uint_as_float(w << 16); }
__device__ __forceinline__ float bfhi(unsigned w) { return __uint_as_float(w & 0xffff0000u); }
__device__ __forceinline__ float sigm(float x) { return __builtin_amdgcn_rcpf(1.0f + __expf(-x)); }
__device__ __forceinline__ float silu(float x) { return x * sigm(x); }
__device__ __forceinline__ float wave_sum(float v) {
#pragma unroll
    for (int o = 32; o >= 1; o >>= 1) v += __shfl_xor(v, o);
    return v;
}
__device__ __forceinline__ u32x2 pack4(f32x4 v) { u32x2 w; w.x = cvt_pk_bf16(v[0], v[1]); w.y = cvt_pk_bf16(v[2], v[3]); return w; }
__device__ __forceinline__ f32x4 unpack4(u32x2 w) { return (f32x4){bflo(w.x), bfhi(w.x), bflo(w.y), bfhi(w.y)}; }
union FragU { u32x4 u; bf16x8 v; };
__device__ __forceinline__ u32x4 pack8(f32x4 a, f32x4 b) { u32x4 w; w.x = cvt_pk_bf16(a[0], a[1]); w.y = cvt_pk_bf16(a[2], a[3]); w.z = cvt_pk_bf16(b[0], b[1]); w.w = cvt_pk_bf16(b[2], b[3]); return w; }
__device__ __forceinline__ int perm32(int rho) { const int n = rho >> 4, i = rho & 15; return 8 * (i >> 2) + 4 * n + (i & 3); }
__device__ __forceinline__ bf16x8 ldfrag(const bf16_t* p) { return *(const bf16x8*)p; }
#define MFMA16(a, b, c) __builtin_amdgcn_mfma_f32_16x16x32_bf16((a), (b), (c), 0, 0, 0)

__device__ __forceinline__ int otid() { int t = threadIdx.x; asm volatile("" : "+v"(t)); return t; }
struct Ctx {
    unsigned char* ws; float* out;
#define CXP(name, type, off) __device__ __forceinline__ type* name() const { return (type*)(ws + (off)); }
    CXP(MOD, float, WS_MOD) CXP(SSQQ, float, WS_SSQQ) CXP(SSQKV, float, WS_SSQKV) CXP(ACT, bf16_t, WS_ACT) CXP(H, bf16_t, WS_H) CXP(KVT, float, WS_KVT)
    CXP(F, float, WS_F) CXP(BR, bf16_t, WS_BR) CXP(SCR, float, WS_SCR) CXP(Q, bf16_t, WS_Q) CXP(HGLU, bf16_t, WS_HGLU) CXP(QR, bf16_t, WS_QR)
    CXP(KR, bf16_t, WS_KR) CXP(KRT, bf16_t, WS_KRT) CXP(VRT, bf16_t, WS_VRT) CXP(GR, bf16_t, WS_GR) CXP(MQKV, bf16_t, WS_MQKV) CXP(MG, bf16_t, WS_MG)
    CXP(BG, bf16_t, WS_BG) CXP(KN, bf16_t, WS_KN) CXP(VT, bf16_t, WS_VT) CXP(KROPE, bf16_t, WS_KROPE) CXP(S0T, float, WS_S0T)
#undef CXP
};

constexpr int BM = 256, BK = 64, HALF = 128, HTB = HALF * BK * 2, STAGE_BYTES = 8 * HTB;
constexpr int RS_OFF = STAGE_BYTES + 16;
__device__ __forceinline__ int lds_byte(int r, int c) { const int st = (r >> 4) * 2 + (c >> 5), rr = r & 15, cc = c & 31, ob = rr * 64 + cc * 2; return st * 1024 + (ob ^ (((ob >> 9) & 1) << 5)); }
__device__ __forceinline__ void stage_rc(int b, int& R, int& C) { const int st = b / 1024, sb = b % 1024, swz = sb ^ (((sb >> 9) & 1) << 5); R = (st >> 1) * 16 + swz / 64; C = (st & 1) * 32 + (swz % 64) / 2; }

enum { GT_FFN_IN = 0, GT_FFN_OUT, GT_MIX_IN, GT_M2, GT_BR, GT_MIX_O };
enum { EK_SWIGLU = 0, EK_F32, EK_MIXIN, EK_QUP, EK_KVUP, EK_KVC, EK_BR0, EK_BR1, EK_BR2 };
struct Unit { size_t aoff, boff; int nt, kind, pm, pn, kz; };
struct GemmCall { const char* A; const char* Bt; unsigned ld2; int gt; };

__device__ __forceinline__ void tile_order(int L, int nM, int nN, int& pm, int& pn) {
    const int nwg = nM * nN; int wgid = L;
    { const int q = nwg / 8, r = nwg % 8, xcd = wgid % 8, off = wgid / 8; wgid = (xcd < r ? xcd * (q + 1) : r * (q + 1) + (xcd - r) * q) + off; }
    const int nig = 8 * nN, gid = wgid / nig, fm = gid * 8, gsz = (nM - fm) < 8 ? (nM - fm) : 8;
    pm = fm + ((wgid % nig) % gsz); pn = (wgid % nig) / gsz;
}

__device__ __forceinline__ bool sched_next(const GemmCall& g, int i, int c, int G, Unit& u) {
    const int L = i * G + c;
    u.kz = 0;
    switch (g.gt) {
    case GT_FFN_IN: {
        if (L >= 32 * 22) return false;
        int pm, pn; tile_order(L, 32, 22, pm, pn);
        u.pm = pm; u.pn = pn; u.nt = 16; u.kind = EK_SWIGLU; u.aoff = (size_t)pm * 256 * g.ld2; u.boff = (size_t)pn * 256 * g.ld2; return true; }
    case GT_FFN_OUT: {
        if (L >= 256) return false;
        int pm, pe; tile_order(L, 32, 8, pm, pe);
        u.pm = pm; u.pn = pe >> 1; u.kz = pe & 1; u.nt = 22; u.kind = EK_F32;
        u.aoff = (size_t)pm * 256 * g.ld2 + (size_t)u.kz * 1408 * 2; u.boff = (size_t)u.pn * 256 * g.ld2 + (size_t)u.kz * 1408 * 2; return true; }
    case GT_MIX_IN: {
        if (L >= 1024) return false;
        int pm, pn; tile_order(L, 32, 32, pm, pn);
        u.pm = pm; u.pn = pn; u.nt = 16; u.kind = EK_MIXIN; u.aoff = (size_t)pm * 256 * g.ld2; u.boff = (size_t)pn * 256 * g.ld2; return true; }
    case GT_M2: {
        if (L >= 240) return false;
        if (L < 96) { u.pm = L & 31; u.pn = L >> 5; u.nt = 8; u.kind = EK_QUP; u.aoff = (size_t)u.pm * 256 * g.ld2; u.boff = (size_t)u.pn * 256 * g.ld2; }
        else if (L < 224) { const int t = L - 96; u.pm = t & 31; u.pn = t >> 5; u.nt = 4; u.kind = EK_KVUP; u.aoff = (size_t)u.pm * 256 * g.ld2 + 512 * 2; u.boff = (size_t)(768 + u.pn * 256) * g.ld2; }
        else { const int t = L - 224; u.pm = t & 3; u.pn = t >> 2; u.nt = 4; u.kind = EK_KVC; u.aoff = (size_t)(8192 + u.pm * 256) * g.ld2 + 512 * 2; u.boff = (size_t)(1792 + u.pn * 256) * g.ld2; }
        return true; }
    case GT_BR: {
        int rem = i, slot = -1;
        for (int j = 0;; ++j) { const int sl = j * G + c; if (sl >= 256) return false; const int n = sl < 128 ? 1 : 2; if (rem < n) { slot = sl; break; } rem -= n; }
        if (slot < 128) { u.pm = slot & 31; u.pn = slot >> 5; u.nt = 16; u.kind = EK_BR1; u.aoff = (size_t)u.pm * 256 * g.ld2; u.boff = (size_t)u.pn * 256 * g.ld2; return true; }
        { const int t = slot - 128; u.pm = t & 31; u.pn = t >> 5; u.nt = 8; const int koff = (rem == 0) ? 1024 : 1536; u.kind = (rem == 0) ? EK_BR0 : EK_BR2;
          u.aoff = (size_t)u.pm * 256 * g.ld2 + (size_t)koff * 2; u.boff = (size_t)u.pn * 256 * g.ld2 + (size_t)koff * 2; }
        return true; }
    default: {
        if (L >= 256) return false;
        int pm, pe; tile_order(L, 32, 8, pm, pe);
        u.pm = pm; u.pn = pe >> 1; u.kz = pe & 1; u.nt = 16; u.kind = EK_F32;
        u.aoff = (size_t)pm * 256 * g.ld2 + (size_t)u.kz * 1024 * 2; u.boff = (size_t)u.pn * 256 * g.ld2 + (size_t)u.kz * 1024 * 2; return true; }
    }
}

__device__ __forceinline__ void rope4(f32x4& x1, f32x4& x2, int t, int fq) {
    const float pos = (float)((fq >> 1) ? (t & 63) : (t >> 6));
#pragma unroll
    for (int j = 0; j < 4; ++j) {
        const float fi = (float)(4 * (fq & 1) + j);
        const float ang = pos * exp2f(-fi * 1.6609640474f);
        const float cs = __cosf(ang), sn = __sinf(ang);
        const float a = x1[j], b = x2[j];
        x1[j] = a * cs - b * sn; x2[j] = a * sn + b * cs;
    }
}

__device__ __forceinline__ void epilogue(const Ctx& cx, const Args& a, int l, const f32x4 (&acc)[2][2][4][2], const Unit& u, LAS unsigned char* lds) {
    const int tid_e = otid(), wid_e = __builtin_amdgcn_readfirstlane(tid_e >> 6), wr = wid_e >> 2, wc = wid_e & 3, fr = tid_e & 15, fq = (tid_e & 63) >> 4;
    const int row0 = u.pm * 256 + wr * 64 + fr;
    const int cin0 = wc * 32 + 4 * fq;
    const int cP = wc * 32 + 8 * fq;
    switch (u.kind) {
    case EK_SWIGLU: {
#pragma unroll
        for (int ai = 0; ai < 2; ++ai)
#pragma unroll
            for (int m = 0; m < 4; ++m) {
                const int r = row0 + ai * 128 + m * 16;
                bf16_t* rowp = cx.ACT() + (size_t)r * 2816 + u.pn * 128 + cP;
                f32x4 v[2];
#pragma unroll
                for (int n = 0; n < 2; ++n) {
                    const f32x4 g = acc[ai][0][m][n], up = acc[ai][1][m][n];
#pragma unroll
                    for (int j = 0; j < 4; ++j) v[n][j] = silu(g[j]) * up[j];
                }
                *(u32x4*)rowp = pack8(v[0], v[1]);
            }
    } break;
    case EK_F32: {
#pragma unroll
        for (int ai = 0; ai < 2; ++ai)
#pragma unroll
            for (int m = 0; m < 4; ++m) {
                const int r = row0 + ai * 128 + m * 16;
                bf16_t* rowp = (bf16_t*)cx.F() + ((size_t)u.kz * NTOK + r) * 1024 + u.pn * 256 + cP;
#pragma unroll
                for (int bj = 0; bj < 2; ++bj) *(u32x4*)(rowp + bj * 128) = pack8(acc[ai][bj][m][0], acc[ai][bj][m][1]);
            }
    } break;
    case EK_MIXIN: {
        const int pn = u.pn;
        const int rowbase = (u.pm < 16) ? u.pm * 256 : 4096 + ((u.pm - 16) >> 2) * 1024;
        const int T = (u.pm < 16) ? 256 : 1024;
        if (pn < 4) {
#pragma unroll
            for (int ai = 0; ai < 2; ++ai)
#pragma unroll
                for (int m = 0; m < 4; ++m) {
                    const int r = row0 + ai * 128 + m * 16;
                    bf16_t* rowp = cx.HGLU() + (size_t)r * 512 + pn * 128 + cP;
                    f32x4 v[2];
#pragma unroll
                    for (int n = 0; n < 2; ++n) {
                        const f32x4 av = acc[ai][0][m][n], g = acc[ai][1][m][n];
#pragma unroll
                        for (int j = 0; j < 4; ++j) v[n][j] = av[j] * sigm(g[j]);
                    }
                    *(u32x4*)rowp = pack8(v[0], v[1]);
                }
        } else if (pn < 6) {
#pragma unroll
            for (int ai = 0; ai < 2; ++ai)
#pragma unroll
                for (int m = 0; m < 4; ++m) {
                    const int r = row0 + ai * 128 + m * 16;
                    bf16_t* rowp = cx.QR() + (size_t)r * 512 + (pn - 4) * 256 + cP;
#pragma unroll
                    for (int bj = 0; bj < 2; ++bj) *(u32x4*)(rowp + bj * 128) = pack8(acc[ai][bj][m][0], acc[ai][bj][m][1]);
                }
        } else if (pn < 8) {
            bf16_t* tb = cx.KRT() + (size_t)rowbase * 512;
#pragma unroll
            for (int ai = 0; ai < 2; ++ai)
#pragma unroll
                for (int m = 0; m < 4; ++m) {
                    const int r = row0 + ai * 128 + m * 16;
                    bf16_t* rowp = cx.KR() + (size_t)r * 512 + (pn - 6) * 256 + cin0;
#pragma unroll
                    for (int bj = 0; bj < 2; ++bj)
#pragma unroll
                        for (int n = 0; n < 2; ++n) {
                            const f32x4 v = acc[ai][bj][m][n] * 0.08838834764f;
                            const u32x2 w = pack4(v);
                            *(u32x2*)(rowp + bj * 128 + n * 16) = w;
                            const int col = (pn - 6) * 256 + bj * 128 + n * 16 + cin0;
                            bf16_t* tp = tb + (size_t)col * T + (r - rowbase);
                            tp[0] = (bf16_t)(w.x & 0xffffu); tp[(size_t)T] = (bf16_t)(w.x >> 16); tp[(size_t)2 * T] = (bf16_t)(w.y & 0xffffu); tp[(size_t)3 * T] = (bf16_t)(w.y >> 16);
                        }
                }
        } else if (pn < 12) {
            bf16_t* tb = cx.VRT() + (size_t)rowbase * 1024;
#pragma unroll
            for (int ai = 0; ai < 2; ++ai)
#pragma unroll
                for (int m = 0; m < 4; ++m) {
                    const int r = row0 + ai * 128 + m * 16;
#pragma unroll
                    for (int bj = 0; bj < 2; ++bj)
#pragma unroll
                        for (int n = 0; n < 2; ++n) {
                            const u32x2 w = pack4(acc[ai][bj][m][n]);
                            const int col = (pn - 8) * 256 + bj * 128 + n * 16 + cin0;
                            bf16_t* tp = tb + (size_t)col * T + (r - rowbase);
                            tp[0] = (bf16_t)(w.x & 0xffffu); tp[(size_t)T] = (bf16_t)(w.x >> 16); tp[(size_t)2 * T] = (bf16_t)(w.y & 0xffffu); tp[(size_t)3 * T] = (bf16_t)(w.y >> 16);
                        }
                }
        } else if (pn < 16) {
#pragma unroll
            for (int ai = 0; ai < 2; ++ai)
#pragma unroll
                for (int m = 0; m < 4; ++m) {
                    const int r = row0 + ai * 128 + m * 16;
                    bf16_t* rowp = cx.GR() + (size_t)r * 1024 + (pn - 12) * 256 + cP;
#pragma unroll
                    for (int bj = 0; bj < 2; ++bj) { f32x4 v[2];
#pragma unroll
                        for (int n = 0; n < 2; ++n) { const f32x4 x = acc[ai][bj][m][n];
#pragma unroll
                            for (int j = 0; j < 4; ++j) v[n][j] = silu(x[j]); }
                        *(u32x4*)(rowp + bj * 128) = pack8(v[0], v[1]); }
                }
        } else if (pn < 19) {
            const bool isq = pn < 18;
#pragma unroll
            for (int ai = 0; ai < 2; ++ai)
#pragma unroll
                for (int m = 0; m < 4; ++m) {
                    const int r = row0 + ai * 128 + m * 16;
                    bf16_t* rowp = cx.MQKV() + (size_t)r * 768 + (pn - 16) * 256 + cin0;
                    float s = 0.f;
#pragma unroll
                    for (int bj = 0; bj < 2; ++bj)
#pragma unroll
                        for (int n = 0; n < 2; ++n) { const f32x4 x = acc[ai][bj][m][n]; s += (x[0] * x[0] + x[1] * x[1]) + (x[2] * x[2] + x[3] * x[3]);
                            *(u32x2*)(rowp + bj * 128 + n * 16) = pack4(x); }
                    s += __shfl_xor(s, 16); s += __shfl_xor(s, 32);
                    if (fq == 0) { if (isq) cx.SSQQ()[(size_t)r * 8 + (pn - 16) * 4 + wc] = s; else cx.SSQKV()[(size_t)r * 4 + wc] = s; }
                    if (!isq && r < 4096) {
                        float* o = cx.out + OUT_CKV + ((size_t)((r >> 8) * 2 + l) * 256 + (r & 255)) * 256 + cin0;
#pragma unroll
                        for (int bj = 0; bj < 2; ++bj)
#pragma unroll
                            for (int n = 0; n < 2; ++n) *(f32x4*)(o + bj * 128 + n * 16) = acc[ai][bj][m][n];
                    }
                }
        } else if (pn == 19) {
            if (wc == 0) {
#pragma unroll
                for (int ai = 0; ai < 2; ++ai)
#pragma unroll
                    for (int m = 0; m < 4; ++m) {
                        const int r = row0 + ai * 128 + m * 16;
                        f32x4 x1 = acc[ai][0][m][0], x2 = acc[ai][0][m][1];
                        size_t kr;
                        if (r < 4096) {
                            float* o = cx.out + OUT_KROPE + ((size_t)((r >> 8) * 2 + l) * 256 + (r & 255)) * 32 + (fq >> 1) * 16 + 4 * (fq & 1);
                            *(f32x4*)(o) = x1; *(f32x4*)(o + 8) = x2;
                            kr = (size_t)r;
                        } else {
                            const int rr = r - 4096, t = rr & 1023;
                            rope4(x1, x2, t, fq);
                            kr = (size_t)4096 + (size_t)(rr >> 10) * 1280 + 256 + t;
                        }
                        bf16_t* kp = cx.KROPE() + kr * 32 + 4 * fq;
                        *(u32x2*)(kp) = pack4(x1); *(u32x2*)(kp + 16) = pack4(x2);
                    }
            }
        } else {
#pragma unroll
            for (int ai = 0; ai < 2; ++ai)
#pragma unroll
                for (int m = 0; m < 4; ++m) {
                    const int r = row0 + ai * 128 + m * 16;
                    bf16_t* rowp = cx.BG() + (size_t)r * 3072 + (pn - 20) * 256 + cP;
#pragma unroll
                    for (int bj = 0; bj < 2; ++bj) { f32x4 v[2];
#pragma unroll
                        for (int n = 0; n < 2; ++n) { const f32x4 x = acc[ai][bj][m][n];
#pragma unroll
                            for (int j = 0; j < 4; ++j) v[n][j] = sigm(x[j]); }
                        *(u32x4*)(rowp + bj * 128) = pack8(v[0], v[1]); }
                }
        }
    } break;
    case EK_QUP: {
#pragma unroll
        for (int ai = 0; ai < 2; ++ai)
#pragma unroll
            for (int m = 0; m < 4; ++m) {
                const int r = row0 + ai * 128 + m * 16;
                float rs;
                if (gridDim.x >= 240) rs = *(const LAS float*)(lds + RS_OFF + 4 * (wr * 64 + fr + ai * 128 + m * 16));
                else { const f32x4 s0 = *(const f32x4*)(cx.SSQQ() + (size_t)r * 8), s1 = *(const f32x4*)(cx.SSQQ() + (size_t)r * 8 + 4);
                       rs = rsqrtf((((s0[0] + s0[1]) + (s0[2] + s0[3])) + ((s1[0] + s1[1]) + (s1[2] + s1[3]))) * (1.0f / 512.0f) + 1e-6f) * QSCALE; }
                bf16_t* qrow = cx.Q() + (size_t)r * 768;
                if (u.pn < 2) {
#pragma unroll
                    for (int bj = 0; bj < 2; ++bj)
#pragma unroll
                        for (int n = 0; n < 2; ++n) {
                            const int col = u.pn * 256 + bj * 128 + n * 16 + cin0;
                            *(u32x2*)(qrow + (col >> 6) * 96 + (col & 63)) = pack4(acc[ai][bj][m][n] * rs);
                        }
                } else {
#pragma unroll
                    for (int bj = 0; bj < 2; ++bj) {
                        f32x4 x1 = acc[ai][bj][m][0] * rs, x2 = acc[ai][bj][m][1] * rs;
                        if (r >= 4096) rope4(x1, x2, (r - 4096) & 1023, fq);
                        bf16_t* qp = qrow + (4 * bj + wc) * 96 + 64 + 4 * fq;
                        *(u32x2*)(qp) = pack4(x1); *(u32x2*)(qp + 16) = pack4(x2);
                    }
                }
            }
    } break;
    case EK_KVUP:
    case EK_KVC: {
        const bool cache = (u.kind == EK_KVC);
        int kbase, Tk, joff;
        if (cache) { kbase = 4096 + 1280 * u.pm; Tk = 1280; joff = 0; }
        else if (u.pm < 16) { kbase = 256 * u.pm; Tk = 256; joff = 0; }
        else { const int b = (u.pm - 16) >> 2; kbase = 4096 + 1280 * b; Tk = 1280; joff = 256 + ((u.pm - 16) & 3) * 256; }
#pragma unroll
        for (int ai = 0; ai < 2; ++ai)
#pragma unroll
            for (int m = 0; m < 4; ++m) {
                const int lr_ = wr * 64 + fr + ai * 128 + m * 16;
                const int r = u.pm * 256 + lr_;
                float rs = 1.0f;
                if (!cache) {
                    if (gridDim.x >= 240) rs = *(const LAS float*)(lds + RS_OFF + 4 * lr_);
                    else { const f32x4 s0 = *(const f32x4*)(cx.SSQKV() + (size_t)r * 4); rs = rsqrtf(((s0[0] + s0[1]) + (s0[2] + s0[3])) * (1.0f / 256.0f) + 1e-6f); }
                }
                const int jpos = joff + lr_;
#pragma unroll
                for (int bj = 0; bj < 2; ++bj) {
                    const int head = 2 * u.pn + bj;
#pragma unroll
                    for (int n = 0; n < 2; ++n) {
                        const u32x2 w = pack4(acc[ai][bj][m][n] * rs);
                        if (wc < 2) {
                            *(u32x2*)(cx.KN() + (size_t)(kbase + jpos) * 512 + head * 64 + wc * 32 + n * 16 + 4 * fq) = w;
                        } else {
                            const int dv = (wc - 2) * 32 + n * 16 + 4 * fq;
                            bf16_t* tp = cx.VT() + (size_t)kbase * 512 + (size_t)(head * 64 + dv) * Tk + jpos;
                            tp[0] = (bf16_t)(w.x & 0xffffu); tp[(size_t)Tk] = (bf16_t)(w.x >> 16); tp[(size_t)2 * Tk] = (bf16_t)(w.y & 0xffffu); tp[(size_t)3 * Tk] = (bf16_t)(w.y >> 16);
                        }
                    }
                }
            }
    } break;
    case EK_BR0:
    case EK_BR1:
    case EK_BR2: {
        const int gofs = (u.kind == EK_BR0) ? 0 : (u.kind == EK_BR1 ? 1024 : 2048);
        __builtin_assume_separate_storage(cx.BG(), cx.MG()); __builtin_assume_separate_storage(cx.BG(), cx.SCR()); __builtin_assume_separate_storage(cx.SCR(), cx.MG());
#pragma unroll
        for (int ai = 0; ai < 2; ++ai)
#pragma unroll
            for (int m = 0; m < 4; ++m) {
                const int r = row0 + ai * 128 + m * 16;
                const int colb = u.pn * 256 + cP;
                u32x4 gw[2]; u32x4 sv[2];
#pragma unroll
                for (int bj = 0; bj < 2; ++bj) {
                    gw[bj] = *(const u32x4*)(cx.BG() + (size_t)r * 3072 + gofs + colb + bj * 128);
                    if (u.kind == EK_BR2) sv[bj] = *(const u32x4*)((const bf16_t*)cx.SCR() + (size_t)r * 1024 + colb + bj * 128);
                }
#pragma unroll
                for (int bj = 0; bj < 2; ++bj) {
                    const int col = colb + bj * 128;
                    const f32x4 g0 = (f32x4){bflo(gw[bj].x), bfhi(gw[bj].x), bflo(gw[bj].y), bfhi(gw[bj].y)}, g1 = (f32x4){bflo(gw[bj].z), bfhi(gw[bj].z), bflo(gw[bj].w), bfhi(gw[bj].w)};
                    f32x4 v0 = acc[ai][bj][m][0] * g0, v1 = acc[ai][bj][m][1] * g1;
                    if (u.kind == EK_BR0) { *(u32x4*)((bf16_t*)cx.SCR() + (size_t)r * 1024 + col) = pack8(v0, v1); }
                    else if (u.kind == EK_BR1) { *(u32x4*)(cx.MG() + (size_t)r * 2048 + col) = pack8(v0, v1); }
                    else { v0 += (f32x4){bflo(sv[bj].x), bfhi(sv[bj].x), bflo(sv[bj].y), bfhi(sv[bj].y)}; v1 += (f32x4){bflo(sv[bj].z), bfhi(sv[bj].z), bflo(sv[bj].w), bfhi(sv[bj].w)}; *(u32x4*)(cx.MG() + (size_t)r * 2048 + 1024 + col) = pack8(v0, v1); }
                }
            }
    } break;
    default: break;
    }
}

__device__ __forceinline__ void gemm_phase(LAS unsigned char* lds, const GemmCall g, const Ctx& cx, const Args& a, int l) {
    const int tid = otid(), wid = __builtin_amdgcn_readfirstlane(tid >> 6), lane = tid & 63, wr = wid >> 2, wc = wid & 3, fr = lane & 15, fq = lane >> 4;
    const int G = gridDim.x, cidx = blockIdx.x;
    unsigned voffA[2];
#pragma unroll
    for (int i = 0; i < 2; ++i) { int R, C; stage_rc(tid * 16 + i * 8192, R, C); voffA[i] = (unsigned)R * g.ld2 + (unsigned)C * 2u; }
    const size_t kstep = (size_t)(BK * 2);
    const size_t hstepA = (size_t)HALF * g.ld2;
    const unsigned ldsw = (unsigned)wid * 1024u;
    const int aoff = lds_byte(wr * 64 + fr, fq * 8), boff = lds_byte(wc * 32 + fr, fq * 8);
#define PG8_SA(b, h) (((b) * 2 + (h)) * HTB)
#define PG8_SB(b, h) ((4 + (b) * 2 + (h)) * HTB)
#define PG8_STAGE(bufoff, gbase, voff) do { _Pragma("unroll") for (int _i = 0; _i < 2; ++_i) \
        __builtin_amdgcn_global_load_lds((const unsigned*)((const char*)(gbase) + (voff)[_i]), (LAS unsigned*)(lds + (bufoff) + ldsw + _i * 8192), 16, 0, 0); } while (0)
#define PG8_LDA(dst, b, h) do { _Pragma("unroll") for (int m = 0; m < 4; ++m) _Pragma("unroll") for (int k = 0; k < 2; ++k) dst[m][k] = *(const LAS bf16x8*)(lds + PG8_SA(b, h) + aoff + m * 2048 + k * 1024); } while (0)
#define PG8_LDB(dst, b, h) do { _Pragma("unroll") for (int n = 0; n < 2; ++n) _Pragma("unroll") for (int k = 0; k < 2; ++k) dst[n][k] = *(const LAS bf16x8*)(lds + PG8_SB(b, h) + boff + n * 2048 + k * 1024); } while (0)
#define PG8_MMA(ai, bj, At, Bt) do { __builtin_amdgcn_s_setprio(1); _Pragma("unroll") for (int m = 0; m < 4; ++m) _Pragma("unroll") for (int n = 0; n < 2; ++n) _Pragma("unroll") for (int k = 0; k < 2; ++k) \
        acc[ai][bj][m][n] = __builtin_amdgcn_mfma_f32_16x16x32_bf16(Bt[n][k], At[m][k], acc[ai][bj][m][n], 0, 0, 0); __builtin_amdgcn_s_setprio(0); } while (0)
#define PG8_WAIT_V(n) asm volatile("s_waitcnt vmcnt(" #n ")" ::: "memory")
#define PG8_WAIT_L(n) asm volatile("s_waitcnt lgkmcnt(" #n ")" ::: "memory")
#define PG8_BAR __builtin_amdgcn_s_barrier()
#define PG8_SCHED __builtin_amdgcn_sched_barrier(0)
    Unit cur, nxt; int ui = 0;
    if (!sched_next(g, 0, cidx, G, cur)) return;
    f32x4 acc[2][2][4][2];
#pragma unroll
    for (int x = 0; x < 2; ++x)
#pragma unroll
        for (int b = 0; b < 2; ++b)
#pragma unroll
            for (int m = 0; m < 4; ++m)
#pragma unroll
                for (int n = 0; n < 2; ++n) acc[x][b][m][n] = (f32x4){0.f, 0.f, 0.f, 0.f};
    bf16x8 At[4][2], B0[2][2], B1[2][2];
    const char* cA = g.A + cur.aoff; const char* cB = g.Bt + cur.boff;
    PG8_STAGE(PG8_SB(0, 0), cB, voffA); PG8_STAGE(PG8_SA(0, 0), cA, voffA); PG8_STAGE(PG8_SB(0, 1), cB + hstepA, voffA); PG8_STAGE(PG8_SA(0, 1), cA + hstepA, voffA);
    if (wr == 1) PG8_BAR;
    PG8_WAIT_V(4); PG8_BAR;
    PG8_STAGE(PG8_SB(1, 0), cB + kstep, voffA); PG8_STAGE(PG8_SA(1, 0), cA + kstep, voffA); PG8_STAGE(PG8_SB(1, 1), cB + hstepA + kstep, voffA);
    PG8_WAIT_V(6); PG8_BAR;
    for (;;) {
        const bool has_next = sched_next(g, ui + 1, cidx, G, nxt);
        const char* nA = has_next ? g.A + nxt.aoff : cA; const char* nB = has_next ? g.Bt + nxt.boff : cB;
        const int nt = cur.nt;
        for (int t = 0; t < nt; t += 2) {
            const bool last = (t == nt - 2);
            const char* a1 = cA + (size_t)(t + 1) * kstep;
            const char* a2 = last ? nA : cA + (size_t)(t + 2) * kstep; const char* b2 = last ? nB : cB + (size_t)(t + 2) * kstep;
            const char* a3 = a2 + kstep; const char* b3 = b2 + kstep;
            PG8_LDB(B0, 0, 0); PG8_SCHED; PG8_LDA(At, 0, 0); PG8_STAGE(PG8_SA(1, 1), a1 + hstepA, voffA);
            PG8_WAIT_L(8); PG8_BAR; PG8_WAIT_L(0); PG8_MMA(0, 0, At, B0); PG8_BAR; PG8_SCHED;
            PG8_LDB(B1, 0, 1); PG8_STAGE(PG8_SB(0, 0), b2, voffA);
            PG8_BAR; PG8_WAIT_L(0); PG8_MMA(0, 1, At, B1); PG8_BAR;
            PG8_LDA(At, 0, 1); PG8_STAGE(PG8_SA(0, 0), a2, voffA);
            PG8_BAR; PG8_WAIT_L(0); PG8_MMA(1, 0, At, B0); PG8_BAR; PG8_SCHED;
            PG8_STAGE(PG8_SB(0, 1), b2 + hstepA, voffA);
            PG8_WAIT_V(6); PG8_BAR; PG8_MMA(1, 1, At, B1); PG8_BAR;
            PG8_LDB(B0, 1, 0); PG8_SCHED; PG8_LDA(At, 1, 0); PG8_STAGE(PG8_SA(0, 1), a2 + hstepA, voffA);
            PG8_WAIT_L(8); PG8_BAR; PG8_WAIT_L(0); PG8_MMA(0, 0, At, B0); PG8_BAR; PG8_SCHED;
            PG8_LDB(B1, 1, 1); PG8_STAGE(PG8_SB(1, 0), b3, voffA);
            PG8_BAR; PG8_WAIT_L(0); PG8_MMA(0, 1, At, B1); PG8_BAR;
            PG8_LDA(At, 1, 1); PG8_STAGE(PG8_SA(1, 0), a3, voffA);
            PG8_BAR; PG8_WAIT_L(0); PG8_MMA(1, 0, At, B0); PG8_BAR; PG8_SCHED;
            PG8_STAGE(PG8_SB(1, 1), b3 + hstepA, voffA);
            PG8_WAIT_V(6); PG8_BAR; PG8_MMA(1, 1, At, B1); PG8_BAR;
        }
        epilogue(cx, a, l, acc, cur, lds);
        if (!has_next) break;
#pragma unroll
        for (int x = 0; x < 2; ++x)
#pragma unroll
            for (int b = 0; b < 2; ++b)
#pragma unroll
                for (int m = 0; m < 4; ++m)
#pragma unroll
                    for (int n = 0; n < 2; ++n) acc[x][b][m][n] = (f32x4){0.f, 0.f, 0.f, 0.f};
        cur = nxt; cA = nA; cB = nB; ++ui;
    }
    PG8_WAIT_V(0);
    if (wr == 0) PG8_BAR;
    PG8_BAR;
#undef PG8_SA
#undef PG8_SB
#undef PG8_STAGE
#undef PG8_LDA
#undef PG8_LDB
#undef PG8_MMA
#undef PG8_WAIT_V
#undef PG8_WAIT_L
#undef PG8_BAR
#undef PG8_SCHED
}

__device__ __forceinline__ int rope_src(int dp) { const int n = dp >> 4, ip = dp & 15; return (ip >> 3) * 16 + n * 8 + (ip & 7); }
__device__ __forceinline__ int mixin_src_col(int n) {
    const int t = n >> 8, w = n & 255;
    if (t < 4) return (w >> 7) * 512 + t * 128 + (w & 127);
    if (t < 6) return 1024 + (t - 4) * 256 + w;
    if (t < 8) return 1536 + (t - 6) * 256 + w;
    if (t < 12) return 2048 + (t - 8) * 256 + w;
    if (t < 16) return 3072 + (t - 12) * 256 + w;
    if (t < 18) return 4096 + (t - 16) * 256 + w;
    if (t == 18) return 4608 + w;
    if (t == 19) return (w < 32) ? 4864 + rope_src(w) : -1;
    return 4896 + (t - 20) * 256 + w;
}
constexpr int PREP_TILES = 352 + 176 + 352 + 176 + 512 + 24 + 16 + 16 + 128 + 128;

__device__ __forceinline__ void prep_tile(const Args& a, int l, int T, unsigned char* smem) {
    bf16_t* tile = (bf16_t*)smem;
    const int tid = otid(), nn = tid & 63, kq = tid >> 6;
    int job, t = T;
    if (t < 352) job = 0; else if ((t -= 352) < 176) job = 1; else if ((t -= 176) < 352) job = 2; else if ((t -= 352) < 176) job = 3;
    else if ((t -= 176) < 512) job = 4; else if ((t -= 512) < 24) job = 5; else if ((t -= 24) < 16) job = 6; else if ((t -= 16) < 16) job = 7;
    else if ((t -= 16) < 128) job = 8; else { t -= 128; job = 9; }
    const float* src = nullptr; const float* kscale = nullptr; size_t ld = 0; int ksrc0 = 0, col = 0, n0 = 0, k0 = 0; size_t ldd = 0; bf16_t* dst = nullptr;
    unsigned char* W = a.ws;
    switch (job) {
    case 0: case 2: { const int tk = t & 3, tn = t >> 2; n0 = tn * 64; k0 = tk * 256; const int n = ((n0 + nn) & ~31) + perm32((n0 + nn) & 31);
        src = a.in[job == 0 ? I_F1IN : I_F2IN] + (size_t)l * 1024 * 5632; ld = 5632; ksrc0 = k0;
        col = ((n & 255) >> 7) * 2816 + (n >> 8) * 128 + (n & 127); dst = (bf16_t*)(W + (job == 0 ? W_FFN1_IN : W_FFN2_IN)); ldd = 1024; } break;
    case 1: case 3: { const int tk = t % 11, tn = t / 11; n0 = tn * 64; k0 = tk * 256;
        src = a.in[job == 1 ? I_F1OUT : I_F2OUT] + (size_t)l * 2816 * 1024; ld = 1024; ksrc0 = k0; col = ((n0 + nn) & ~31) + perm32((n0 + nn) & 31);
        dst = (bf16_t*)(W + (job == 1 ? W_FFN1_OUT : W_FFN2_OUT)); ldd = 2816; } break;
    case 4: { const int tk = t & 3, tn = t >> 2; n0 = tn * 64; k0 = tk * 256;
        src = a.in[I_MIXIN] + (size_t)l * 1024 * 7968; ld = 7968; ksrc0 = k0; { const int n = n0 + nn, tt = n >> 8; const bool pm_ = (tt < 6) || (tt >= 12 && tt < 16) || (tt >= 20); col = mixin_src_col(pm_ ? (n & ~31) + perm32(n & 31) : n); } dst = (bf16_t*)(W + W_MIX_IN); ldd = 1024; } break;
    case 5: { const int tk = t & 1, tn = t >> 1; n0 = tn * 64; k0 = tk * 256; const int n = n0 + nn, tt = n >> 8, w = n & 255;
        src = a.in[I_WUQ] + (size_t)l * 512 * 768; ld = 768; ksrc0 = k0; kscale = a.in[I_QNORM] + l * 512;
        col = (tt < 2) ? (4 * tt + (w >> 6)) * 96 + (w & 63) : (w >> 5) * 96 + 64 + rope_src(w & 31);
        dst = (bf16_t*)(W + W_M2); ldd = 768; } break;
    case 6: case 7: { n0 = t * 64; k0 = 0;
        src = a.in[I_WUKV] + (size_t)l * 256 * 1024; ld = 1024; ksrc0 = 0; col = n0 + nn; if (job == 6) kscale = a.in[I_KVNORM] + l * 256;
        dst = (bf16_t*)(W + W_M2) + (size_t)(job == 6 ? 768 : 1792) * 768; ldd = 768; } break;
    case 8: { const int tk = t & 7, tn = t >> 3; n0 = tn * 64; k0 = tk * 256; col = ((n0 + nn) & ~31) + perm32((n0 + nn) & 31); ld = 1024;
        if (k0 < 1024) { src = a.in[I_RWOUT] + (size_t)l * 1024 * 1024; ksrc0 = k0; }
        else if (k0 < 1536) { src = a.in[I_CWOUT] + (size_t)l * 512 * 1024; ksrc0 = k0 - 1024; }
        else { src = a.in[I_MWOUT] + (size_t)l * 512 * 1024; ksrc0 = k0 - 1536; }
        dst = (bf16_t*)(W + W_BR); ldd = 2048; } break;
    default: { const int tk = t & 7, tn = t >> 3; n0 = tn * 64; k0 = tk * 256; col = ((n0 + nn) & ~31) + perm32((n0 + nn) & 31); ld = 1024;
        src = a.in[I_WO] + (size_t)l * 1024 * 1024; ksrc0 = k0 & 1023; dst = (bf16_t*)(W + W_O2); ldd = 2048; } break;
    }
    {
        const float* sp = src + (size_t)ksrc0 * ld + (col >= 0 ? col : 0);
        float v0[16], v1[16];
#pragma unroll
        for (int i = 0; i < 16; ++i) { const int kk = 2 * (kq + 8 * i); v0[i] = sp[(size_t)kk * ld]; v1[i] = sp[(size_t)(kk + 1) * ld]; }
#pragma unroll
        for (int i = 0; i < 16; ++i) {
            const int kk = 2 * (kq + 8 * i);
            float x0 = v0[i], x1 = v1[i];
            if (kscale) { x0 *= kscale[ksrc0 + kk]; x1 *= kscale[ksrc0 + kk + 1]; }
            if (col < 0) { x0 = 0.f; x1 = 0.f; }
            *(unsigned*)(tile + nn * 264 + kk) = cvt_pk_bf16(x0, x1);
        }
    }
    __syncthreads();
#pragma unroll
    for (int j = 0; j < 4; ++j) {
        const int idx = tid + 512 * j, nn2 = idx >> 5, kk8 = (idx & 31) * 8;
        *(u32x4*)(dst + (size_t)(n0 + nn2) * ldd + k0 + kk8) = *(const u32x4*)(tile + nn2 * 264 + kk8);
    }
    __syncthreads();
}

__device__ __forceinline__ void ada_phase(const Args& a, const Ctx& cx, unsigned char* smem) {
    float* sl = (float*)smem;
    float* red = (float*)(smem + 20480);
    const int tid = otid();
    for (int e = tid; e < 5 * 1024; e += 512) { const int ci = e >> 10, k = e & 1023; const float x = (ci == 0) ? a.in[I_CCTX][k] : a.in[I_C][(ci - 1) * 1024 + k]; sl[e] = silu(x); }
    __syncthreads();
    const int cgp = tid & 15, kg = tid >> 4;
    for (int task = (int)gridDim.x - 1 - (int)blockIdx.x; task < 288; task += gridDim.x) {
        const int l = task / 144, col0 = (task % 144) * 64;
        f32x4 acc[5];
#pragma unroll
        for (int ci = 0; ci < 5; ++ci) acc[ci] = (f32x4){0.f, 0.f, 0.f, 0.f};
        const float* wp = a.in[I_ADAW] + ((size_t)l * 1024 + kg * 32) * 9216 + col0 + cgp * 4;
#pragma unroll 4
        for (int kk = 0; kk < 32; ++kk) {
            const f32x4 w = *(const f32x4*)(wp + (size_t)kk * 9216);
#pragma unroll
            for (int ci = 0; ci < 5; ++ci) acc[ci] += w * sl[ci * 1024 + kg * 32 + kk];
        }
#pragma unroll
        for (int ci = 0; ci < 5; ++ci) *(f32x4*)(red + (kg * 5 + ci) * 64 + cgp * 4) = acc[ci];
        __syncthreads();
        if (tid < 320) {
            const int ci = tid >> 6, cc = tid & 63; float s = 0.f;
            for (int k2 = 0; k2 < 32; ++k2) s += red[(k2 * 5 + ci) * 64 + cc];
            cx.MOD()[((size_t)l * 5 + ci) * 9216 + col0 + cc] = s + a.in[I_ADAB][(size_t)l * 9216 + col0 + cc];
        }
        __syncthreads();
    }
}

#ifndef LN_NR
#define LN_NR 4
#endif
__device__ __forceinline__ void ln_phase(const Args& a, const Ctx& cx, int l, int s) {
    const int tid_ = otid(), lane = tid_ & 63, wave = tid_ >> 6;
    float* X = cx.out;
    const int nl = (s < 0) ? 0 : (s == 2 ? l + 1 : l), nm = (s < 0) ? 0 : (s == 2 ? 0 : 3 * (s + 1));
    const bool have_h = (nl < 2);
    const int rstride = gridDim.x * 8;
    for (int row0 = blockIdx.x * 8 + wave; row0 < NTOK; row0 += LN_NR * rstride) {
        f32x4 xn[LN_NR][4];
        int rows[LN_NR], cis[LN_NR];
#pragma unroll
        for (int rr = 0; rr < LN_NR; ++rr) { int r = row0 + rr * rstride; if (r >= NTOK) r = row0; rows[rr] = r; cis[rr] = r < 4096 ? 0 : 1 + ((r - 4096) >> 10); }
        if (s < 0) {
#pragma unroll
            for (int rr = 0; rr < LN_NR; ++rr) {
                const int row = rows[rr];
                const float* xp = (row < 4096) ? a.in[I_XP] + (size_t)row * 1024 : a.in[I_XS] + (size_t)(row - 4096) * 1024;
#pragma unroll
                for (int q = 0; q < 4; ++q) xn[rr][q] = *(const f32x4*)(xp + q * 256 + lane * 4);
            }
        } else {
            const float gs = (s == 1) ? 1.0f : 0.5f;
            float sum[LN_NR]; for (int rr = 0; rr < LN_NR; ++rr) sum[rr] = 0.f;
#pragma unroll
            for (int rr = 0; rr < LN_NR; ++rr) {
                const int row = rows[rr];
                const float* modl = cx.MOD() + ((size_t)l * 5 + cis[rr]) * 9216 + (3 * s + 2) * 1024;
                const float* xres = (l == 0 && s == 0) ? ((row < 4096) ? a.in[I_XP] + (size_t)row * 1024 : a.in[I_XS] + (size_t)(row - 4096) * 1024) : X + (size_t)row * 1024;
                const bf16_t* f0 = (const bf16_t*)cx.F() + (size_t)row * 1024; const bf16_t* f1 = (const bf16_t*)cx.F() + ((size_t)NTOK + row) * 1024;
#pragma unroll
                for (int q = 0; q < 4; ++q) {
                    const int c = q * 256 + lane * 4;
                    const f32x4 xo = *(const f32x4*)(xres + c), g = *(const f32x4*)(modl + c), p0 = unpack4(*(const u32x2*)(f0 + c)), p1 = unpack4(*(const u32x2*)(f1 + c));
                    xn[rr][q] = xo * ALPHA + (g * gs) * (p0 + p1);
                    sum[rr] += (xn[rr][q][0] + xn[rr][q][1]) + (xn[rr][q][2] + xn[rr][q][3]);
                }
            }
            const float* lg = a.in[I_LNG] + (size_t)(l * 3 + s) * 1024; const float* lb = a.in[I_LNB] + (size_t)(l * 3 + s) * 1024;
#pragma unroll
            for (int rr = 0; rr < LN_NR; ++rr) {
                const float mean = wave_sum(sum[rr]) * (1.0f / 1024.0f);
                float sq = 0.f;
#pragma unroll
                for (int q = 0; q < 4; ++q) { xn[rr][q] = xn[rr][q] - mean; sq += (xn[rr][q][0] * xn[rr][q][0] + xn[rr][q][1] * xn[rr][q][1]) + (xn[rr][q][2] * xn[rr][q][2] + xn[rr][q][3] * xn[rr][q][3]); }
                const float rstd = rsqrtf(wave_sum(sq) * (1.0f / 1024.0f) + 1e-5f);
#pragma unroll
                for (int q = 0; q < 4; ++q) {
                    const int c = q * 256 + lane * 4;
                    xn[rr][q] = xn[rr][q] * rstd * *(const f32x4*)(lg + c) + *(const f32x4*)(lb + c);
                    *(f32x4*)(X + (size_t)rows[rr] * 1024 + c) = xn[rr][q];
                }
            }
        }
        if (have_h) {
#pragma unroll
            for (int rr = 0; rr < LN_NR; ++rr) {
                const float* mn = cx.MOD() + ((size_t)nl * 5 + cis[rr]) * 9216 + nm * 1024;
#pragma unroll
                for (int q = 0; q < 4; ++q) {
                    const int c = q * 256 + lane * 4;
                    const f32x4 sh = *(const f32x4*)(mn + c), sc = *(const f32x4*)(mn + 1024 + c);
                    *(u32x2*)(cx.H() + (size_t)rows[rr] * 1024 + c) = pack4(xn[rr][q] * (sc + 1.0f) + sh);
                }
            }
        }
    }
}

__device__ __forceinline__ void cache_prep(const Args& a, const Ctx& cx, int l) {
    const size_t gtid = (size_t)blockIdx.x * 512 + otid(), gsz = (size_t)gridDim.x * 512;
    for (size_t e = gtid; e < 1024 * 64; e += gsz) {
        const int rr = (int)(e >> 6), c4 = (int)(e & 63) * 4, b = rr >> 8, t = rr & 255;
        const f32x4 v = *(const f32x4*)(a.in[I_CKV] + (((size_t)b * 2 + l) * 256 + t) * 256 + c4);
        *(u32x2*)(cx.MQKV() + (size_t)(8192 + rr) * 768 + 512 + c4) = pack4(v);
    }
    for (size_t e = gtid; e < 1024 * 32; e += gsz) {
        const int rr = (int)(e >> 5), dp = (int)(e & 31), b = rr >> 8, t = rr & 255;
        const float v = a.in[I_CKR][(((size_t)b * 2 + l) * 256 + t) * 32 + rope_src(dp)];
        cx.KROPE()[(size_t)(4096 + 1280 * b + t) * 32 + dp] = f2bf(v);
    }
    for (size_t e = gtid; e < (size_t)16 * 2 * 32768; e += gsz) {
        const int dv = (int)(e & 255), dk = (int)((e >> 8) & 127), dir = (int)((e >> 15) & 1), bh = (int)(e >> 16), b = bh >> 2, h = bh & 3;
        const float v = a.in[dir ? I_SB : I_SF][((((size_t)b * 2 + l) * 4 + h) * 128 + dk) * 256 + dv];
        cx.S0T()[((size_t)bh * 2 + dir) * 32768 + (size_t)dv * 128 + dk] = v;
    }
}

__device__ __forceinline__ void conv_rows(const Args& a, const Ctx& cx, int l, unsigned char* smem) {
    const int tid_ = otid(), lane = tid_ & 63, wave = tid_ >> 6;
    float* wl = (float*)smem;
    {
        const float* wsrc = a.in[I_CWDW] + (size_t)l * 31 * 512;
        for (int e = tid_; e < 31 * 128; e += 512) *(f32x4*)(wl + e * 4) = *(const f32x4*)(wsrc + e * 4);
    }
    __syncthreads();
    for (int rgp = blockIdx.x * 8 + wave; rgp < NTOK / 4; rgp += gridDim.x * 8) {
        const int row0 = rgp * 4;
        int rowbase, T, t0;
        if (row0 < 4096) { rowbase = row0 & ~255; t0 = row0 & 255; T = 256; } else { rowbase = 4096 + ((row0 - 4096) & ~1023); t0 = (row0 - 4096) & 1023; T = 1024; }
        f32x4 c0[4], c1[4];
#pragma unroll
        for (int i = 0; i < 4; ++i) { c0[i] = *(const f32x4*)(a.in[I_CBDW] + l * 512 + lane * 8); c1[i] = *(const f32x4*)(a.in[I_CBDW] + l * 512 + lane * 8 + 4); }
#pragma unroll
        for (int jc = 0; jc < 5; ++jc) {
            u32x4 raw[8]; float vld[8];
#pragma unroll
            for (int jj = 0; jj < 8; ++jj) {
                const int j = jc * 8 + jj;
                if (j < 34) {
                    const int tt = t0 - 15 + j;
                    const int ttc = tt < 0 ? 0 : (tt >= T ? T - 1 : tt);
                    vld[jj] = (tt >= 0 && tt < T) ? 1.0f : 0.0f;
                    raw[jj] = *(const u32x4*)(cx.HGLU() + (size_t)(rowbase + ttc) * 512 + lane * 8);
                }
            }
#pragma unroll
            for (int jj = 0; jj < 8; ++jj) {
                const int j = jc * 8 + jj;
                if (j < 34) {
                    const f32x4 x0 = (f32x4){bflo(raw[jj].x), bfhi(raw[jj].x), bflo(raw[jj].y), bfhi(raw[jj].y)} * vld[jj];
                    const f32x4 x1 = (f32x4){bflo(raw[jj].z), bfhi(raw[jj].z), bflo(raw[jj].w), bfhi(raw[jj].w)} * vld[jj];
#pragma unroll
                    for (int i = 0; i < 4; ++i) {
                        const int tap = j - i;
                        if (tap >= 0 && tap < 31) {
                            c0[i] += x0 * *(const f32x4*)(wl + tap * 512 + lane * 8);
                            c1[i] += x1 * *(const f32x4*)(wl + tap * 512 + lane * 8 + 4);
                        }
                    }
                }
            }
        }
        const float* lg = a.in[I_CLNG] + l * 512 + lane * 8; const float* lb = a.in[I_CLNB] + l * 512 + lane * 8;
        const f32x4 g0 = *(const f32x4*)(lg), g1 = *(const f32x4*)(lg + 4), b0 = *(const f32x4*)(lb), b1 = *(const f32x4*)(lb + 4);
#pragma unroll
        for (int i = 0; i < 4; ++i) {
            f32x4 y0 = c0[i], y1 = c1[i];
            const float mean = wave_sum((y0[0] + y0[1]) + (y0[2] + y0[3]) + (y1[0] + y1[1]) + (y1[2] + y1[3])) * (1.0f / 512.0f);
            y0 = y0 - mean; y1 = y1 - mean;
            const float var = wave_sum((y0[0] * y0[0] + y0[1] * y0[1]) + (y0[2] * y0[2] + y0[3] * y0[3]) + (y1[0] * y1[0] + y1[1] * y1[1]) + (y1[2] * y1[2] + y1[3] * y1[3])) * (1.0f / 512.0f);
            const float rstd = rsqrtf(var + 1e-5f);
            y0 = y0 * rstd * g0 + b0; y1 = y1 * rstd * g1 + b1;
#pragma unroll
            for (int j = 0; j < 4; ++j) { y0[j] = silu(y0[j]); y1[j] = silu(y1[j]); }
            u32x4 w; w.x = cvt_pk_bf16(y0[0], y0[1]); w.y = cvt_pk_bf16(y0[2], y0[3]); w.z = cvt_pk_bf16(y1[0], y1[1]); w.w = cvt_pk_bf16(y1[2], y1[3]);
            *(u32x4*)(cx.BR() + (size_t)(row0 + i) * 2048 + 1024 + lane * 8) = w;
        }
    }
    __syncthreads();
}

__device__ __forceinline__ void ckv_out_rows(const Args& a, const Ctx& cx, int l) {
    const int tid_ = otid(), lane = tid_ & 63, wave = tid_ >> 6;
    const f32x4 g = *(const f32x4*)(a.in[I_KVNORM] + l * 256 + lane * 4);
    for (int row = blockIdx.x * 8 + wave; row < 4096; row += gridDim.x * 8) {
        const f32x4 s0 = *(const f32x4*)(cx.SSQKV() + (size_t)row * 4);
        const float rs = rsqrtf(((s0[0] + s0[1]) + (s0[2] + s0[3])) * (1.0f / 256.0f) + 1e-6f);
        float* o = cx.out + OUT_CKV + ((size_t)((row >> 8) * 2 + l) * 256 + (row & 255)) * 256 + lane * 4;
        *(f32x4*)o = *(const f32x4*)o * rs * g;
    }
}

struct RetUnit { int rowbase, T, h, c, bh; bool ctx; };
__device__ __forceinline__ RetUnit ret_decode(int u) {
    RetUnit r;
    if (u < 128) { r.ctx = true; r.bh = u >> 1; r.h = (u & 7) >> 1; r.c = u & 1; r.rowbase = (u >> 3) * 256; r.T = 256; }
    else { const int v = u - 128; r.ctx = false; r.bh = v >> 3; r.h = (v & 31) >> 3; r.c = v & 7; r.rowbase = 4096 + (v >> 5) * 1024; r.T = 1024; }
    return r;
}
__device__ __forceinline__ float log2_sigmoid(float x) { return -log2f(1.0f + expf(-x)); }

__device__ __forceinline__ void r1_unit(const Args& a, const Ctx& cx, int l, int u, unsigned char* smem) {
    const RetUnit ru = ret_decode(u);
    const int tid_ = otid(), lane = tid_ & 63, wave = tid_ >> 6, lr = lane & 15, lg = lane >> 4;
    const float lgf = log2_sigmoid(a.in[I_RDF][l * 4 + ru.h]), lgb = log2_sigmoid(a.in[I_RDB][l * 4 + ru.h]);
    const size_t T = (size_t)ru.T;
    const bf16_t* vT = cx.VRT() + (size_t)ru.rowbase * 1024 + (size_t)(ru.h * 256) * T + ru.c * 128;
    const bf16_t* kT = cx.KRT() + (size_t)ru.rowbase * 512 + (size_t)(ru.h * 128) * T + ru.c * 128;
    bf16_t* kTs = (bf16_t*)smem;
    bf16_t* vTs = (bf16_t*)(smem + 34816);
    {
        u32x4 kr[4], vr[8];
#pragma unroll
        for (int j = 0; j < 4; ++j) { const int idx = tid_ + 512 * j; kr[j] = *(const u32x4*)(kT + (size_t)(idx >> 4) * T + (idx & 15) * 8); }
#pragma unroll
        for (int j = 0; j < 8; ++j) { const int idx = tid_ + 512 * j; vr[j] = *(const u32x4*)(vT + (size_t)(idx >> 4) * T + (idx & 15) * 8); }
#pragma unroll
        for (int j = 0; j < 4; ++j) { const int idx = tid_ + 512 * j; *(u32x4*)(kTs + (idx >> 4) * 136 + (idx & 15) * 8) = kr[j]; }
#pragma unroll
        for (int j = 0; j < 8; ++j) { const int idx = tid_ + 512 * j; *(u32x4*)(vTs + (idx >> 4) * 136 + (idx & 15) * 8) = vr[j]; }
    }
    __syncthreads();
#pragma unroll 1
    for (int dir = 0; dir < 2; ++dir) {
        const float lgd = dir ? lgb : lgf;
        f32x4 acc[2][8];
#pragma unroll
        for (int mt = 0; mt < 2; ++mt)
#pragma unroll
            for (int nt = 0; nt < 8; ++nt) acc[mt][nt] = (f32x4){0.f, 0.f, 0.f, 0.f};
#pragma unroll
        for (int ks = 0; ks < 4; ++ks) {
            const int j0 = ks * 32 + lg * 8;
            float z[8];
#pragma unroll
            for (int e = 0; e < 8; ++e) z[e] = __builtin_amdgcn_exp2f((float)(dir ? (j0 + e) : 127 - (j0 + e)) * lgd);
            bf16x8 af[2];
#pragma unroll
            for (int mt = 0; mt < 2; ++mt) {
                const u32x4 raw = *(const u32x4*)(vTs + (wave * 32 + mt * 16 + lr) * 136 + j0);
                FragU f;
                f.u.x = cvt_pk_bf16(bflo(raw.x) * z[0], bfhi(raw.x) * z[1]); f.u.y = cvt_pk_bf16(bflo(raw.y) * z[2], bfhi(raw.y) * z[3]);
                f.u.z = cvt_pk_bf16(bflo(raw.z) * z[4], bfhi(raw.z) * z[5]); f.u.w = cvt_pk_bf16(bflo(raw.w) * z[6], bfhi(raw.w) * z[7]);
                af[mt] = f.v;
            }
#pragma unroll
            for (int nt = 0; nt < 8; ++nt) {
                const bf16x8 kf = *(const bf16x8*)(kTs + (nt * 16 + lr) * 136 + j0);
#pragma unroll
                for (int mt = 0; mt < 2; ++mt) acc[mt][nt] = MFMA16(kf, af[mt], acc[mt][nt]);
            }
        }
        float* o = cx.KVT() + ((size_t)u * 2 + dir) * 32768;
        if (ru.ctx) {
#pragma unroll
            for (int mt = 0; mt < 2; ++mt)
#pragma unroll
                for (int nt = 0; nt < 8; ++nt) *(f32x4*)(o + (wave * 32 + mt * 16 + lr) * 128 + nt * 16 + lg * 4) = acc[mt][nt];
        } else {
            bf16_t* ob = (bf16_t*)o;
#pragma unroll
            for (int mt = 0; mt < 2; ++mt)
#pragma unroll
                for (int nt = 0; nt < 8; ++nt) *(u32x2*)(ob + (wave * 32 + mt * 16 + lr) * 128 + nt * 16 + lg * 4) = pack4(acc[mt][nt]);
        }
    }
    __syncthreads();
}

__device__ __forceinline__ void r2_unit(const Args& a, const Ctx& cx, int l, int u, unsigned char* smem) {
    const RetUnit ru = ret_decode(u);
    const int tid = otid(), lane = tid & 63, wave = tid >> 6, lr = lane & 15, lg = lane >> 4;
    const float lgf = log2_sigmoid(a.in[I_RDF][l * 4 + ru.h]), lgb = log2_sigmoid(a.in[I_RDB][l * 4 + ru.h]);
    const size_t T = (size_t)ru.T;
    bf16_t* Sbuf = (bf16_t*)smem;
    bf16_t* Pw = (bf16_t*)(smem + 69632) + wave * (16 * 136);
    const int crow = ru.rowbase + ru.c * 128;
    const int il = wave * 16 + lr;
    bf16x8 qf[4];
#pragma unroll
    for (int ks = 0; ks < 4; ++ks) qf[ks] = ldfrag(cx.QR() + (size_t)(crow + il) * 512 + ru.h * 128 + ks * 32 + lg * 8);
    const bf16_t* vT = cx.VRT() + (size_t)ru.rowbase * 1024 + (size_t)(ru.h * 256) * T + ru.c * 128;
    {
        u32x4 kreg[4];
#pragma unroll
        for (int j = 0; j < 4; ++j) { const int idx = tid + 512 * j; kreg[j] = *(const u32x4*)(cx.KR() + (size_t)(crow + (idx >> 4)) * 512 + ru.h * 128 + (idx & 15) * 8); }
#pragma unroll
        for (int j = 0; j < 4; ++j) { const int idx = tid + 512 * j; *(u32x4*)(Sbuf + (idx >> 4) * 136 + (idx & 15) * 8) = kreg[j]; }
    }
    __syncthreads();
    u32x4 vreg[8];
#pragma unroll
    for (int j = 0; j < 8; ++j) { const int idx = tid + 512 * j; vreg[j] = *(const u32x4*)(vT + (size_t)(idx >> 4) * T + (idx & 15) * 8); }
#pragma unroll
    for (int nt = 0; nt < 8; ++nt) {
        f32x4 sa = (f32x4){0.f, 0.f, 0.f, 0.f};
#pragma unroll
        for (int ks = 0; ks < 4; ++ks) { const bf16x8 kf = *(const bf16x8*)(Sbuf + (nt * 16 + lr) * 136 + ks * 32 + lg * 8); sa = MFMA16(kf, qf[ks], sa); }
        f32x4 p;
#pragma unroll
        for (int rg = 0; rg < 4; ++rg) { const int j = nt * 16 + lg * 4 + rg, d = il - j; p[rg] = sa[rg] * __builtin_amdgcn_exp2f(d >= 0 ? (float)d * lgf : (float)(-d) * lgb); }
        *(u32x2*)(Pw + lr * 136 + nt * 16 + lg * 4) = pack4(p);
    }
    __syncthreads();
#pragma unroll
    for (int j = 0; j < 8; ++j) { const int idx = tid + 512 * j; *(u32x4*)(Sbuf + (idx >> 4) * 136 + (idx & 15) * 8) = vreg[j]; }
    bf16x8 pf[4];
#pragma unroll
    for (int ks = 0; ks < 4; ++ks) pf[ks] = *(const bf16x8*)(Pw + lr * 136 + ks * 32 + lg * 8);
    __syncthreads();
    f32x4 oacc[16];
#pragma unroll
    for (int nt2 = 0; nt2 < 16; ++nt2) {
        f32x4 o = (f32x4){0.f, 0.f, 0.f, 0.f};
#pragma unroll
        for (int ks = 0; ks < 4; ++ks) { const bf16x8 vf = *(const bf16x8*)(Sbuf + (nt2 * 16 + lr) * 136 + ks * 32 + lg * 8); o = MFMA16(vf, pf[ks], o); }
        oacc[nt2] = o;
    }
    const int nc = ru.ctx ? 2 : 8;
    for (int dir = 0; dir < 2; ++dir) {
        const bool have = ru.ctx ? (dir == 0 ? ru.c == 1 : ru.c == 0) : true;
        if (!have) continue;
        const float lgd = dir ? lgb : lgf;
        __syncthreads();
        {
            int nterm;
            if (ru.ctx) nterm = 1; else nterm = dir == 0 ? ru.c + 1 : nc - ru.c;
#pragma unroll 1
            for (int hf = 0; hf < 2; ++hf) {
                f32x4 sacc[8];
#pragma unroll
                for (int it = 0; it < 8; ++it) sacc[it] = (f32x4){0.f, 0.f, 0.f, 0.f};
                if (ru.ctx) {
                    const float* p = cx.KVT() + ((size_t)(dir == 0 ? u - 1 : u + 1) * 2 + dir) * 32768;
#pragma unroll
                    for (int it = 0; it < 8; ++it) sacc[it] = *(const f32x4*)(p + (size_t)((hf * 8 + it) * 512 + tid) * 4);
                } else {
                    {
                        const float* p = cx.S0T() + ((size_t)ru.bh * 2 + dir) * 32768;
                        const float w = exp2f((float)((dir == 0 ? ru.c : nc - 1 - ru.c) * 128) * lgd);
#pragma unroll
                        for (int it = 0; it < 8; ++it) sacc[it] = *(const f32x4*)(p + (size_t)((hf * 8 + it) * 512 + tid) * 4) * w;
                    }
                    for (int m = 1; m < nterm; m += 4) {
                        const bf16_t* p[4]; float w[4];
#pragma unroll
                        for (int q = 0; q < 4; ++q) {
                            const int mm = (m + q < nterm) ? m + q : m;
                            if (dir == 0) { p[q] = (const bf16_t*)(cx.KVT() + ((size_t)(u - ru.c + (mm - 1)) * 2 + 0) * 32768); w[q] = exp2f((float)((ru.c - mm) * 128) * lgd); }
                            else { p[q] = (const bf16_t*)(cx.KVT() + ((size_t)(u + mm) * 2 + 1) * 32768); w[q] = exp2f((float)((mm - 1) * 128) * lgd); }
                            if (m + q >= nterm) w[q] = 0.f;
                        }
                        u32x2 ldq[4][8];
#pragma unroll
                        for (int q = 0; q < 4; ++q)
#pragma unroll
                            for (int it = 0; it < 8; ++it) ldq[q][it] = *(const u32x2*)(p[q] + (size_t)((hf * 8 + it) * 512 + tid) * 4);
#pragma unroll
                        for (int q = 0; q < 4; ++q)
#pragma unroll
                            for (int it = 0; it < 8; ++it) sacc[it] += unpack4(ldq[q][it]) * w[q];
                    }
                }
#pragma unroll
                for (int it = 0; it < 8; ++it) { const int e4 = (hf * 8 + it) * 512 + tid; *(u32x2*)(Sbuf + (e4 >> 5) * 136 + (e4 & 31) * 4) = pack4(sacc[it]); }
            }
        }
        __syncthreads();
        const float xi = dir == 0 ? exp2f((float)(il + 1) * lgf) : exp2f((float)(128 - il) * lgb);
#pragma unroll
        for (int nt2 = 0; nt2 < 16; ++nt2) {
            f32x4 cacc = (f32x4){0.f, 0.f, 0.f, 0.f};
#pragma unroll
            for (int ks = 0; ks < 4; ++ks) { const bf16x8 sf = *(const bf16x8*)(Sbuf + (nt2 * 16 + lr) * 136 + ks * 32 + lg * 8); cacc = MFMA16(sf, qf[ks], cacc); }
            oacc[nt2] += cacc * xi;
        }
    }
    float sum = 0.f;
#pragma unroll
    for (int nt2 = 0; nt2 < 16; ++nt2) sum += (oacc[nt2][0] + oacc[nt2][1]) + (oacc[nt2][2] + oacc[nt2][3]);
    sum += __shfl_xor(sum, 16); sum += __shfl_xor(sum, 32);
    const float mean = sum * (1.0f / 256.0f);
    float sq = 0.f;
#pragma unroll
    for (int nt2 = 0; nt2 < 16; ++nt2) { oacc[nt2] = oacc[nt2] - mean; sq += (oacc[nt2][0] * oacc[nt2][0] + oacc[nt2][1] * oacc[nt2][1]) + (oacc[nt2][2] * oacc[nt2][2] + oacc[nt2][3] * oacc[nt2][3]); }
    sq += __shfl_xor(sq, 16); sq += __shfl_xor(sq, 32);
    const float rstd = rsqrtf(sq * (1.0f / 256.0f) + 1e-5f);
    const size_t row = (size_t)(crow + il);
    u32x2 gts[16];
#pragma unroll
    for (int nt2 = 0; nt2 < 16; ++nt2) gts[nt2] = *(const u32x2*)(cx.GR() + row * 1024 + ru.h * 256 + nt2 * 16 + lg * 4);
#pragma unroll
    for (int nt2 = 0; nt2 < 16; ++nt2) {
        const int col = ru.h * 256 + nt2 * 16 + lg * 4;
        *(u32x2*)(cx.BR() + row * 2048 + col) = pack4(oacc[nt2] * rstd * unpack4(gts[nt2]));
    }
    if (ru.ctx) {
        const int c = ru.c, s = u >> 3;
        float* o = cx.out + (c == 0 ? OUT_RF : OUT_RB) + ((size_t)(s * 2 + l) * 4 + ru.h) * 32768;
        const float* A = cx.KVT() + ((size_t)u * 2 + c) * 32768;
        const float* B = cx.KVT() + ((size_t)(c == 0 ? u + 1 : u - 1) * 2 + c) * 32768;
        const float w = exp2f(128.0f * (c == 0 ? lgf : lgb));
        float* Tt = (float*)smem;
#pragma unroll 1
        for (int q4 = 0; q4 < 4; ++q4) {
            __syncthreads();
            f32x4 va[4], vb[4];
#pragma unroll
            for (int j = 0; j < 4; ++j) { const int idx = tid + 512 * j, dvl = idx >> 5, dk4 = (idx & 31) * 4; va[j] = *(const f32x4*)(A + (q4 * 64 + dvl) * 128 + dk4); vb[j] = *(const f32x4*)(B + (q4 * 64 + dvl) * 128 + dk4); }
#pragma unroll
            for (int j = 0; j < 4; ++j) { const int idx = tid + 512 * j, dvl = idx >> 5, dk4 = (idx & 31) * 4; const f32x4 r = va[j] * w + vb[j];
                Tt[dvl * 129 + dk4] = r[0]; Tt[dvl * 129 + dk4 + 1] = r[1]; Tt[dvl * 129 + dk4 + 2] = r[2]; Tt[dvl * 129 + dk4 + 3] = r[3]; }
            __syncthreads();
#pragma unroll
            for (int j = 0; j < 4; ++j) { const int idx = tid + 512 * j, dk = idx >> 4, dq = (idx & 15) * 4;
                const f32x4 r = (f32x4){Tt[dq * 129 + dk], Tt[(dq + 1) * 129 + dk], Tt[(dq + 2) * 129 + dk], Tt[(dq + 3) * 129 + dk]};
                *(f32x4*)(o + dk * 256 + q4 * 64 + dq) = r; }
        }
    }
    __syncthreads();
}

__device__ __forceinline__ void attn_unit(const Ctx& cx, int uidx, unsigned char* smem) {
    const int tid = otid(), lane = tid & 63, wave = tid >> 6, lr = lane & 15, lg = lane >> 4;
    int qrow0, head, kbase, Tk;
    if (uidx < 256) { const int b = uidx >> 6; head = (uidx & 63) >> 3; qrow0 = 4096 + b * 1024 + (uidx & 7) * 128; kbase = 4096 + 1280 * b; Tk = 1280; }
    else { const int v = uidx - 256, b = v >> 4; head = (v & 15) >> 1; qrow0 = b * 256 + (v & 1) * 128; kbase = b * 256; Tk = 256; }
    constexpr int BUFB = 23552, KR_OFF = 9216, VT_OFF = 14336;
    bf16_t* Pw = (bf16_t*)(smem + 2 * BUFB) + wave * (16 * 72);
    const size_t row = (size_t)(qrow0 + wave * 16 + lr);
    bf16x8 qf[3];
#pragma unroll
    for (int ks = 0; ks < 3; ++ks) qf[ks] = ldfrag(cx.Q() + row * 768 + head * 96 + ks * 32 + lg * 8);
    const int r8 = tid >> 3, s8 = tid & 7, r4 = (tid >> 2) & 63, s4 = tid & 3;
    const bf16_t* gk = cx.KN() + (size_t)(kbase + r8) * 512 + head * 64 + s8 * 8;
    const bf16_t* gv = cx.VT() + (size_t)kbase * 512 + (size_t)(head * 64 + r8) * Tk + s8 * 8;
    const bf16_t* gr = cx.KROPE() + (size_t)(kbase + r4) * 32 + s4 * 8;
    const int lk = r8 * 72 + s8 * 8, lrp = r4 * 40 + s4 * 8;
    const int nkb = Tk / 64;
    u32x4 pk = *(const u32x4*)gk, pv = *(const u32x4*)gv, pr = *(const u32x4*)gr;
    {
        bf16_t* b0 = (bf16_t*)smem;
        *(u32x4*)(b0 + lk) = pk; *(u32x4*)(b0 + VT_OFF / 2 + lk) = pv; if (tid < 256) *(u32x4*)(b0 + KR_OFF / 2 + lrp) = pr;
    }
    __syncthreads();
    float m_run = -1e30f, l_part = 0.f;
    f32x4 oacc[4];
#pragma unroll
    for (int i = 0; i < 4; ++i) oacc[i] = (f32x4){0.f, 0.f, 0.f, 0.f};
    for (int kb = 0; kb < nkb; ++kb) {
        const bool more = kb + 1 < nkb;
        if (more) { const size_t k1 = (size_t)(kb + 1) * 64; pk = *(const u32x4*)(gk + k1 * 512); pv = *(const u32x4*)(gv + k1); pr = *(const u32x4*)(gr + k1 * 32); }
        const bf16_t* cb = (const bf16_t*)(smem + (kb & 1) * BUFB);
        f32x4 s[4];
#pragma unroll
        for (int nt = 0; nt < 4; ++nt) {
            const bf16x8 k0 = *(const bf16x8*)(cb + (nt * 16 + lr) * 72 + lg * 8), k1 = *(const bf16x8*)(cb + (nt * 16 + lr) * 72 + 32 + lg * 8),
                         k2 = *(const bf16x8*)(cb + KR_OFF / 2 + (nt * 16 + lr) * 40 + lg * 8);
            f32x4 z = (f32x4){0.f, 0.f, 0.f, 0.f};
            z = MFMA16(k0, qf[0], z); z = MFMA16(k1, qf[1], z); z = MFMA16(k2, qf[2], z);
            s[nt] = z;
        }
        float mx = -1e30f;
#pragma unroll
        for (int nt = 0; nt < 4; ++nt) mx = fmaxf(mx, fmaxf(fmaxf(s[nt][0], s[nt][1]), fmaxf(s[nt][2], s[nt][3])));
        mx = fmaxf(mx, __shfl_xor(mx, 16)); mx = fmaxf(mx, __shfl_xor(mx, 32));
        const float m_new = fmaxf(m_run, mx), alpha = __builtin_amdgcn_exp2f(m_run - m_new);
        m_run = m_new;
        float ps = 0.f;
#pragma unroll
        for (int nt = 0; nt < 4; ++nt) {
#pragma unroll
            for (int rg = 0; rg < 4; ++rg) { s[nt][rg] = __builtin_amdgcn_exp2f(s[nt][rg] - m_new); ps += s[nt][rg]; }
            *(u32x2*)(Pw + lr * 72 + nt * 16 + lg * 4) = pack4(s[nt]);
        }
        l_part = l_part * alpha + ps;
#pragma unroll
        for (int i = 0; i < 4; ++i) oacc[i] = oacc[i] * alpha;
        bf16x8 pf[2];
#pragma unroll
        for (int ks = 0; ks < 2; ++ks) pf[ks] = *(const bf16x8*)(Pw + lr * 72 + ks * 32 + lg * 8);
#pragma unroll
        for (int nt2 = 0; nt2 < 4; ++nt2)
#pragma unroll
            for (int ks = 0; ks < 2; ++ks) { const bf16x8 vf = *(const bf16x8*)(cb + VT_OFF / 2 + (nt2 * 16 + lr) * 72 + ks * 32 + lg * 8); oacc[nt2] = MFMA16(vf, pf[ks], oacc[nt2]); }
        if (more) {
            bf16_t* nb = (bf16_t*)(smem + ((kb + 1) & 1) * BUFB);
            *(u32x4*)(nb + lk) = pk; *(u32x4*)(nb + VT_OFF / 2 + lk) = pv; if (tid < 256) *(u32x4*)(nb + KR_OFF / 2 + lrp) = pr;
        }
        __syncthreads();
    }
    float lt = l_part + __shfl_xor(l_part, 16); lt += __shfl_xor(lt, 32);
    const float inv = 1.0f / lt;
#pragma unroll
    for (int nt2 = 0; nt2 < 4; ++nt2) *(u32x2*)(cx.BR() + row * 2048 + 1536 + head * 64 + nt2 * 16 + lg * 4) = pack4(oacc[nt2] * inv);
}

__device__ __forceinline__ void grid_barrier(unsigned* cnt, unsigned target) {
    asm volatile("s_waitcnt vmcnt(0) lgkmcnt(0)" ::: "memory");
    __syncthreads();
    if (threadIdx.x == 0) {
        __builtin_amdgcn_fence(__ATOMIC_RELEASE, "agent");
        asm volatile("s_waitcnt vmcnt(0)" ::: "memory");
        __hip_atomic_fetch_add(cnt, 1u, __ATOMIC_RELAXED, __HIP_MEMORY_SCOPE_AGENT);
        while (__hip_atomic_load(cnt, __ATOMIC_RELAXED, __HIP_MEMORY_SCOPE_AGENT) < target) __builtin_amdgcn_s_sleep(1);
        __builtin_amdgcn_fence(__ATOMIC_ACQUIRE, "agent");
        asm volatile("s_waitcnt vmcnt(0)" ::: "memory");
    }
    __syncthreads();
}

#define XB_XCNT(j)  (256  + 64 * (j))
#define XB_XSUB(j)  (1280 + 64 * (j))
#define XB_XGEN(j)  (2304 + 64 * (j))
#define XB_TOP      3328
#define XB_TOPGEN   3392
__device__ __forceinline__ unsigned xb_ld(unsigned* p)              { return __hip_atomic_load(p, __ATOMIC_RELAXED, __HIP_MEMORY_SCOPE_AGENT); }
__device__ __forceinline__ unsigned xb_add(unsigned* p, unsigned v) { return __hip_atomic_fetch_add(p, v, __ATOMIC_RELAXED, __HIP_MEMORY_SCOPE_AGENT); }
__device__ __forceinline__ unsigned xb_xcc_id() { return (unsigned)__builtin_amdgcn_s_getreg((3 << 11) | 20) & 0xFu; }
__device__ __forceinline__ void xcd_barrier(unsigned* bar, volatile unsigned* st) {
    asm volatile("s_waitcnt vmcnt(0) lgkmcnt(0)" ::: "memory");
    __syncthreads();
    if (threadIdx.x == 0) {
        const unsigned x = xb_xcc_id();
        unsigned nloc = st[0], nx = st[1];
        if (nloc == 0u) {
            unsigned cntx = 0u, mine = 0u;
#pragma unroll
            for (unsigned j = 0; j < 16; ++j) { const unsigned c = xb_ld(&bar[XB_XCNT(j)]); cntx += (c > 0u) ? 1u : 0u; mine = (j == x) ? c : mine; }
            nloc = mine > 0u ? mine : 1u; nx = cntx > 0u ? cntx : 1u; st[0] = nloc; st[1] = nx;
        }
        const unsigned old = xb_add(&bar[XB_XSUB(x)], 1u);
        const unsigned gen = old / nloc;
        if (old + 1u == (gen + 1u) * nloc) {
            __builtin_amdgcn_fence(__ATOMIC_RELEASE, "agent");
            asm volatile("s_waitcnt vmcnt(0)" ::: "memory");
            const unsigned og = xb_add(&bar[XB_TOP], 1u);
            const unsigned tg = og / nx;
            if (og + 1u == (tg + 1u) * nx) xb_add(&bar[XB_TOPGEN], 1u);
            else while (xb_ld(&bar[XB_TOPGEN]) == tg) __builtin_amdgcn_s_sleep(1);
            __builtin_amdgcn_fence(__ATOMIC_ACQUIRE, "agent");
            xb_add(&bar[XB_XGEN(x)], 1u);
            asm volatile("s_waitcnt vmcnt(0)" ::: "memory");
        } else {
            while (xb_ld(&bar[XB_XGEN(x)]) == gen) __builtin_amdgcn_s_sleep(1);
            __builtin_amdgcn_fence(__ATOMIC_ACQUIRE, "agent");
            asm volatile("s_waitcnt vmcnt(0)" ::: "memory");
        }
    }
    __syncthreads();
}

__global__ void __launch_bounds__(512) mk_fwd(Args a) {
    extern __shared__ __attribute__((aligned(16))) unsigned char smem[];
    Ctx cx;
    cx.ws = a.ws; cx.out = a.out;
    LAS unsigned char* lds = (LAS unsigned char*)smem;
    const int G = gridDim.x;
    unsigned* const gbar = (unsigned*)(a.ws + WS_BAR);
    unsigned bar_round = 0;
    if (a.ph_hi > 1000) cg::this_grid().sync();
    volatile unsigned* const bst = (volatile unsigned*)(smem + STAGE_BYTES);
    if (threadIdx.x == 0) { bst[0] = 0u; bst[1] = 0u; (void)xb_add(&gbar[XB_XCNT(xb_xcc_id())], 1u); }
    __syncthreads();
#define GRID_SYNC() do { ++bar_round; if (bar_round == 1u) grid_barrier(gbar, (unsigned)G); else xcd_barrier(gbar, bst); } while (0)

    for (int ph = a.ph_lo; ph < a.ph_hi; ++ph) {
        cx.ws = a.ws; cx.out = a.out; asm volatile("" : "+s"(cx.ws), "+s"(cx.out));
        int l = 0, k = -1;
        if (ph >= 2) { l = (ph - 2) / 12; k = (ph - 2) % 12; }
        const int nrep = 1 + ((MK_REPEAT_MASK >> (ph == 0 ? 12 : (ph == 1 ? 13 : k))) & 1);
        for (int rep = 0; rep < nrep; ++rep) {
        bool do_gemm = false; GemmCall g; g.A = nullptr; g.Bt = nullptr; g.ld2 = 0; g.gt = 0;
        if (ph == 0) {
            if (G == 256) {
                const int c = blockIdx.x;
                if (c < 224) for (int t = c; t < 1792; t += 224) prep_tile(a, 0, t, smem);
                else for (int t = 1792 + (c - 224); t < PREP_TILES; t += 32) prep_tile(a, 0, t, smem);
            } else {
                for (int t = blockIdx.x; t < PREP_TILES; t += G) prep_tile(a, 0, t, smem);
            }
            ada_phase(a, cx, smem);
        } else if (ph == 1) {
            ln_phase(a, cx, 0, -1);
        } else {
            switch (k) {
            case 0: do_gemm = true; g.A = (const char*)cx.H(); g.Bt = (const char*)(a.ws + W_FFN1_IN); g.ld2 = 2048; g.gt = GT_FFN_IN; break;
            case 1: do_gemm = true; g.A = (const char*)cx.ACT(); g.Bt = (const char*)(a.ws + W_FFN1_OUT); g.ld2 = 5632; g.gt = GT_FFN_OUT; break;
            case 2: ln_phase(a, cx, l, 0); break;
            case 3: cache_prep(a, cx, l); do_gemm = true; g.A = (const char*)cx.H(); g.Bt = (const char*)(a.ws + W_MIX_IN); g.ld2 = 2048; g.gt = GT_MIX_IN; break;
            case 4:
                conv_rows(a, cx, l, smem);
                ckv_out_rows(a, cx, l);
                for (int u = blockIdx.x; u < 256; u += G) r1_unit(a, cx, l, u, smem);
                do_gemm = true; g.A = (const char*)cx.MQKV(); g.Bt = (const char*)(a.ws + W_M2); g.ld2 = 1536; g.gt = GT_M2;
                if (G >= 240) {
                    Unit u0; const int t = otid();
                    if (sched_next(g, 0, blockIdx.x, G, u0) && t < 256) {
                        const int r = u0.pm * 256 + t; float rs = 1.0f;
                        if (u0.kind == EK_QUP) { const f32x4 s0 = *(const f32x4*)(cx.SSQQ() + (size_t)r * 8), s1 = *(const f32x4*)(cx.SSQQ() + (size_t)r * 8 + 4);
                            rs = rsqrtf((((s0[0] + s0[1]) + (s0[2] + s0[3])) + ((s1[0] + s1[1]) + (s1[2] + s1[3]))) * (1.0f / 512.0f) + 1e-6f) * QSCALE; }
                        else if (u0.kind == EK_KVUP) { const f32x4 s0 = *(const f32x4*)(cx.SSQKV() + (size_t)r * 4); rs = rsqrtf(((s0[0] + s0[1]) + (s0[2] + s0[3])) * (1.0f / 256.0f) + 1e-6f); }
                        *(float*)(smem + RS_OFF + 4 * t) = rs;
                    }
                }
                __syncthreads();
                g.A = (const char*)cx.MQKV(); g.Bt = (const char*)(a.ws + W_M2); g.ld2 = 1536; g.gt = GT_M2; break;
            case 5:
                for (int u = blockIdx.x; u < 256; u += G) r2_unit(a, cx, l, u, smem);
                for (int u = blockIdx.x; u < 512; u += G) attn_unit(cx, u, smem);
                break;
            case 6: do_gemm = true; g.A = (const char*)cx.BR(); g.Bt = (const char*)(a.ws + W_BR); g.ld2 = 4096; g.gt = GT_BR; break;
            case 7: do_gemm = true; g.A = (const char*)cx.MG(); g.Bt = (const char*)(a.ws + W_O2); g.ld2 = 4096; g.gt = GT_MIX_O; break;
            case 8: ln_phase(a, cx, l, 1); break;
            case 9: do_gemm = true; g.A = (const char*)cx.H(); g.Bt = (const char*)(a.ws + W_FFN2_IN); g.ld2 = 2048; g.gt = GT_FFN_IN; break;
            case 10: do_gemm = true; g.A = (const char*)cx.ACT(); g.Bt = (const char*)(a.ws + W_FFN2_OUT); g.ld2 = 5632; g.gt = GT_FFN_OUT; break;
            default:
                ln_phase(a, cx, l, 2);
                if (l == 0) {
                    if (G == 256) { for (int f = blockIdx.x; f < 1112; f += G) prep_tile(a, 1, f < 528 ? 528 + f : 1296 + (f - 528), smem); }
                    else for (int t = blockIdx.x; t < PREP_TILES; t += G) prep_tile(a, 1, t, smem);
                }
                break;
            }
        }
        if (do_gemm) gemm_phase(lds, g, cx, a, l);
        if (G == 256 && ph >= 2 && k == 6 && l == 0 && rep == 0 && blockIdx.x < 128)
            for (int e = blockIdx.x; e < 768; e += 128) prep_tile(a, 1, e < 528 ? e : e + 528, smem);
        if (rep + 1 < nrep) GRID_SYNC();
        }
        if (ph + 1 < a.ph_hi) GRID_SYNC();
        if ((MK_REPEAT_MASK >> 14) & 1) { if (ph == 5) for (int q = 0; q < 20; ++q) GRID_SYNC(); }
    }
}

constexpr int LDS_BYTES = STAGE_BYTES + 16 + 1024;

extern "C" void kernel_launch(void* const* d_in, const int* in_sizes, int n_in, void* d_out, int out_size, void* d_ws, size_t ws_size, hipStream_t stream) {
    static int grid = 0;
    if (grid == 0) {
        if (n_in != 31 || ws_size < WS_END) { fprintf(stderr, "kernel_launch: unexpected n_in %d or ws_size %zu (< %zu)\n", n_in, ws_size, (size_t)WS_END); grid = -1; return; }
        int dev = 0, cus = 0, per_cu = 0;
        hipGetDevice(&dev);
        hipDeviceGetAttribute(&cus, hipDeviceAttributeMultiprocessorCount, dev);
        if (hipFuncSetAttribute((const void*)mk_fwd, hipFuncAttributeMaxDynamicSharedMemorySize, LDS_BYTES) != hipSuccess) { fprintf(stderr, "kernel_launch: hipFuncSetAttribute failed\n"); grid = -1; return; }
        hipOccupancyMaxActiveBlocksPerMultiprocessor(&per_cu, (const void*)mk_fwd, 512, LDS_BYTES);
        (void)hipGetLastError();
        if (per_cu < 1 || cus < 1) { fprintf(stderr, "kernel_launch: per_cu %d cus %d\n", per_cu, cus); grid = -1; return; }
        grid = cus;
    }
    if (grid < 0) return;
    Args a{};
    for (int i = 0; i < 31; ++i) a.in[i] = (const float*)d_in[i];
    a.out = (float*)d_out; a.ws = (unsigned char*)d_ws;
#if MK_PER_PHASE
    for (int ph = 0; ph < MK_PH_HI; ++ph) {
        a.ph_lo = ph; a.ph_hi = ph + MK_DBG_SPAN;
        hipLaunchKernelGGL(mk_fwd, dim3(grid), dim3(512), LDS_BYTES, stream, a);
    }
#else
    a.ph_lo = 0; a.ph_hi = MK_PH_HI;
    (void)hipMemsetAsync((unsigned char*)d_ws + WS_BAR, 0, 16384, stream);
    void* args[] = {&a};
    hipError_t e = hipLaunchCooperativeKernel((const void*)mk_fwd, dim3(grid), dim3(512), args, LDS_BYTES, stream);
    if (e != hipSuccess) fprintf(stderr, "kernel_launch: cooperative launch failed: %s\n", hipGetErrorString(e));
#endif
}
```
